# Optimizing an MI355X kernel written in HIP

```python
import jax, jax.numpy as jnp
from jax import lax
import numpy as np

D_MODEL = 1024
BATCH = 4
SEQ = 8192
DEPTH = 1

PLE_DIM = 256
GLA_HEADS = 4
GLA_DK = 64
GLA_DV = 128
GLA_KEY = GLA_HEADS * GLA_DK
GLA_VAL = GLA_HEADS * GLA_DV
GLA_RANK = 16
GLA_TAU = 16.0
GLA_CHUNK = 64
CONV_DIM = 512
CONV_GROUPS = 8
CONV_K = 3
D_MIX = GLA_VAL + CONV_DIM
IN_SPLIT_SIZES = (GLA_KEY, GLA_KEY, GLA_VAL, GLA_VAL, GLA_RANK, CONV_DIM, CONV_DIM, CONV_DIM)
D_IN = sum(IN_SPLIT_SIZES)
D_FF = 2816
FFN_K = 3
EPS = 1e-6

kernel_name = "hybrid_gla_shortconv_convffn_ple"


def rmsnorm(x, g):
    xf = x.astype(jnp.float32)
    y = xf * lax.rsqrt(jnp.mean(xf * xf, axis=-1, keepdims=True) + EPS)
    return (y * g.astype(jnp.float32)).astype(x.dtype)


def causal_dwconv(u, w):
    K = w.shape[0]
    S = u.shape[1]
    up = jnp.pad(u, ((0, 0), (K - 1, 0), (0, 0)))
    out = w[K - 1] * u
    for k in range(K - 1):
        out = out + w[k] * up[:, k:k + S]
    return out


def gla_chunked(q, k, v, log_a):
    Bn, S, H, dk = q.shape
    dv = v.shape[-1]
    N = S // GLA_CHUNK

    def to_chunks(t):
        return t.astype(jnp.float32).reshape(Bn, N, GLA_CHUNK, H, t.shape[-1]).transpose(0, 3, 1, 2, 4)

    qc = to_chunks(q) * (dk ** -0.5)
    kc = to_chunks(k)
    vc = to_chunks(v)
    gc = to_chunks(log_a)
    b = jnp.cumsum(gc, axis=-2)
    b_last = b[..., -1:, :]
    q_d = qc * jnp.exp(b)
    k_d = kc * jnp.exp(-b)
    k_end = kc * jnp.exp(b_last - b)

    causal = jnp.tril(jnp.ones((GLA_CHUNK, GLA_CHUNK), dtype=bool))
    scores = jnp.einsum('bhnid,bhnjd->bhnij', q_d, k_d)
    scores = jnp.where(causal, scores, 0.0)
    o_intra = jnp.einsum('bhnij,bhnjv->bhniv', scores, vc)

    U = jnp.einsum('bhnjd,bhnjv->bhndv', k_end, vc)
    decay = jnp.exp(b_last[..., 0, :])

    def step(state, inp):
        dec_n, u_n = inp
        new = dec_n[..., None] * state + u_n
        return new, state

    s0 = jnp.zeros((Bn, H, dk, dv), jnp.float32)
    _, s_prev = lax.scan(step, s0, (jnp.moveaxis(decay, 2, 0), jnp.moveaxis(U, 2, 0)))
    s_prev = jnp.moveaxis(s_prev, 0, 2)
    o_inter = jnp.einsum('bhnid,bhndv->bhniv', q_d, s_prev)
    o = o_intra + o_inter
    return o.transpose(0, 2, 3, 1, 4).reshape(Bn, S, H, dv)


def setup_inputs(seed: int = 0) -> dict:
    key = jax.random.key(seed)
    ks = jax.random.split(key, 20)
    f32 = jnp.float32

    def w(k, shape, fan_in):
        return jax.random.normal(k, shape, f32) * (fan_in ** -0.5)

    def gain(k, shape):
        return 1.0 + 0.02 * jax.random.normal(k, shape, f32)

    return {
        "x": jax.random.normal(ks[0], (BATCH, SEQ, D_MODEL), f32),
        "p": jax.random.normal(ks[1], (DEPTH, BATCH, SEQ, PLE_DIM), f32),
        "attn_norm": gain(ks[2], (DEPTH, D_MODEL)),
        "w_in": w(ks[3], (DEPTH, D_MODEL, D_IN), D_MODEL),
        "w_alpha_up": w(ks[4], (DEPTH, GLA_RANK, GLA_KEY), GLA_RANK),
        "b_alpha": 0.1 * jax.random.normal(ks[5], (DEPTH, GLA_KEY), f32),
        "gla_head_norm": gain(ks[6], (DEPTH, GLA_HEADS, GLA_DV)),
        "mix_conv_w": w(ks[7], (DEPTH, CONV_K, CONV_DIM), CONV_K),
        "w_out": w(ks[8], (DEPTH, D_MIX, D_MODEL), D_MIX),
        "ffn_norm": gain(ks[9], (DEPTH, D_MODEL)),
        "w_up": w(ks[10], (DEPTH, D_MODEL, 2 * D_FF), D_MODEL),
        "ffn_conv_w": w(ks[11], (DEPTH, FFN_K, D_FF), FFN_K),
        "w_down": w(ks[12], (DEPTH, D_FF, D_MODEL), D_FF),
        "ple_norm": gain(ks[13], (DEPTH, D_MODEL)),
        "w_ple_gate": w(ks[14], (DEPTH, D_MODEL, D_MODEL), D_MODEL),
        "w_ple_proj": w(ks[15], (DEPTH, PLE_DIM, D_MODEL), PLE_DIM),
        "final_norm": gain(ks[16], (D_MODEL,)),
    }


def reference(x, p, attn_norm, w_in, w_alpha_up, b_alpha, gla_head_norm, mix_conv_w, w_out,
              ffn_norm, w_up, ffn_conv_w, w_down, ple_norm, w_ple_gate, w_ple_proj, final_norm):
    Bn, S, _ = x.shape
    split_idx = [int(i) for i in np.cumsum(IN_SPLIT_SIZES)[:-1]]
    h = x
    for i in range(DEPTH):
        y = rmsnorm(h, attn_norm[i])
        z = y @ w_in[i]
        q, k, v, g, a_low, cb, cc, cx = jnp.split(z, split_idx, axis=-1)

        a_logit = (a_low @ w_alpha_up[i] + b_alpha[i]).astype(jnp.float32)
        log_a = jax.nn.log_sigmoid(a_logit) / GLA_TAU
        o = gla_chunked(q.reshape(Bn, S, GLA_HEADS, GLA_DK),
                        k.reshape(Bn, S, GLA_HEADS, GLA_DK),
                        v.reshape(Bn, S, GLA_HEADS, GLA_DV),
                        log_a.reshape(Bn, S, GLA_HEADS, GLA_DK))
        o = rmsnorm(o, gla_head_norm[i]).astype(h.dtype)
        o = o * jax.nn.silu(g.reshape(Bn, S, GLA_HEADS, GLA_DV))
        gla_out = o.reshape(Bn, S, GLA_VAL)

        conv_out = cb * causal_dwconv(cc * cx, mix_conv_w[i])

        mix = jnp.concatenate([gla_out, conv_out], axis=-1)
        h = h + mix @ w_out[i]

        y = rmsnorm(h, ffn_norm[i])
        gate, up = jnp.split(y @ w_up[i], 2, axis=-1)
        gate = causal_dwconv(gate, ffn_conv_w[i])
        h = h + (jax.nn.silu(gate) * up) @ w_down[i]

        y = rmsnorm(h, ple_norm[i])
        ple_gate = jax.nn.sigmoid(y @ w_ple_gate[i])
        h = h + ple_gate * (p[i].astype(h.dtype) @ w_ple_proj[i])
    return rmsnorm(h, final_norm)
```

```cpp
#include <hip/hip_runtime.h>
#include <cstdio>
#include <cstdint>

typedef unsigned short bf16;
constexpr int BATCH = 4, SEQ = 8192, T = BATCH * SEQ, DM = 1024, PLE = 256, DIN = 3088, DFF = 2816;
constexpr int NZ = 3072, NIN = 3328, NUP = 2 * DFF;
constexpr int ZQ = 0, ZK = 256, ZV = 512, ZG = 1024, ZCB = 1536, ZCC = 2048, ZCX = 2560;
constexpr float EPS = 1e-6f;
constexpr size_t MiB = 1u << 20;
constexpr size_t WS_CTL = 0;
constexpr size_t WS_WIN = 1 * MiB, WS_WOUT = 8 * MiB, WS_WUP = 10 * MiB, WS_WDN = 21 * MiB, WS_WPG = 27 * MiB, WS_WPP = 29 * MiB;
constexpr size_t WS_SSQ0 = 30 * MiB, WS_SSQ1 = 31 * MiB, WS_SSQ2 = 32 * MiB, WS_SSQ3 = 33 * MiB, WS_DECAY = 34 * MiB;
constexpr size_t WS_GHEAD = 36 * MiB, WS_UHEAD = 39 * MiB, WS_GTAIL = 42 * MiB;
constexpr size_t WS_XB = 48 * MiB;
constexpr size_t WS_Z = 112 * MiB;
constexpr size_t WS_LA = 304 * MiB;
constexpr size_t WS_U = 336 * MiB;
constexpr size_t WS_MIX = 400 * MiB;
constexpr size_t WS_PB = 464 * MiB;
constexpr size_t WS_END = 480 * MiB;

__device__ __forceinline__ unsigned f2bf(float f) { unsigned u = __builtin_bit_cast(unsigned, f); return (u + 0x7fffu + ((u >> 16) & 1u)) >> 16; }
__device__ __forceinline__ float bf2f(bf16 h) { return __builtin_bit_cast(float, (unsigned)h << 16); }
__device__ __forceinline__ float sigmoidf_(float x) { return __builtin_amdgcn_rcpf(1.0f + __builtin_amdgcn_exp2f(-1.44269504089f * x)); }
__device__ __forceinline__ float siluf_(float x) { return x * sigmoidf_(x); }
namespace pg8 {
#define PG8_LAS __attribute__((address_space(3)))
typedef unsigned short bf16_t;
typedef short bf16x8 __attribute__((ext_vector_type(8)));
typedef float f32x4 __attribute__((ext_vector_type(4)));
typedef unsigned u32x4 __attribute__((ext_vector_type(4)));
constexpr int BM = 256, BK = 64, HALF = 128, HTB = HALF * BK * 2  , STAGE_BYTES = 8 * HTB, NXCD = 8, WGM = 8;

__host__ __device__ __forceinline__ int lds_byte(int r, int c) { const int st = (r >> 4) * 2 + (c >> 5), rr = r & 15, cc = c & 31, ob = rr * 64 + cc * 2; return st * 1024 + (ob ^ (((ob >> 9) & 1) << 5)); }
__host__ __device__ __forceinline__ void stage_rc(int b, int& R, int& C) { const int st = b / 1024, sb = b % 1024, swz = sb ^ (((sb >> 9) & 1) << 5); R = (st >> 1) * 16 + swz / 64; C = (st & 1) * 32 + (swz % 64) / 2; }
__host__ __device__ __forceinline__ int perm32(int rho) { const int n = rho >> 4, i = rho & 15; return 8 * (i >> 2) + 4 * n + (i & 3); }

struct Unit { int pm, pn; };
struct Gemm { const bf16_t* A; const bf16_t* Bt; int M, N, K; };

struct StaticOrder {
    int nM, nN, nwg, G, c;
    __host__ __device__ void init(int M, int N, int G_, int c_) { nM = M / BM; nN = N / BM; nwg = nM * nN; G = G_; c = c_; }
    __host__ __device__ bool next(int i, Unit& u) const {
        const long L = (long)i * G + c; if (L >= nwg) return false;
        int wgid = (int)L; { const int q = nwg / NXCD, r = nwg % NXCD, xcd = wgid % NXCD, off = wgid / NXCD; wgid = (xcd < r ? xcd * (q + 1) : r * (q + 1) + (xcd - r) * q) + off; }
        const int nig = WGM * nN, gid = wgid / nig, fm = gid * WGM, gsz = (nM - fm) < WGM ? (nM - fm) : WGM;
        u.pm = fm + ((wgid % nig) % gsz); u.pn = (wgid % nig) / gsz; return true;
    }
    __device__ __forceinline__ void a_ready(const Unit&) const {}
    __device__ __forceinline__ void done(const Unit&) const {}
};


__device__ __forceinline__ unsigned cvt_pk_bf16(float lo, float hi) { unsigned r; asm volatile("v_cvt_pk_bf16_f32 %0, %1, %2" : "=v"(r) : "v"(lo), "v"(hi)); return r; }
__device__ __forceinline__ u32x4 pack8(const f32x4 a, const f32x4 b) { u32x4 w; w.x = cvt_pk_bf16(a[0], a[1]); w.y = cvt_pk_bf16(a[2], a[3]); w.z = cvt_pk_bf16(b[0], b[1]); w.w = cvt_pk_bf16(b[2], b[3]); return w; }
__device__ __forceinline__ float fast_sigmoid(float x) { return __builtin_amdgcn_rcpf(1.0f + __builtin_amdgcn_exp2f(-1.44269504089f * x)); }
__device__ __forceinline__ float rstd_sum4(const float* p4) { const f32x4 s = *(const f32x4*)p4; return __builtin_amdgcn_rsqf(((s[0] + s[1]) + (s[2] + s[3])) * (1.0f / 1024.0f) + 1e-6f); }
__device__ __forceinline__ float logsig16(float x) { const float e = __builtin_amdgcn_exp2f(-1.44269504089f * __builtin_fabsf(x)); return (__builtin_fminf(x, 0.f) - 0.69314718056f * __builtin_amdgcn_logf(1.0f + e)) * 0.0625f; }

struct EpiIn {
    static constexpr bool PERM = true, AFTER_DRAIN = false;
    const float* ssq0; const float* b_alpha; bf16_t* z; float* la;
    __device__ __forceinline__ void operator()(f32x4 (&acc)[2][2][4][2], const Unit& u, int wr, int wc, int fr, int fq, PG8_LAS unsigned char*, int) const {
        const int row0 = u.pm * BM + wr * 64 + fr, colw = wc * 32 + 8 * fq;
        if (u.pn < 12) {
#pragma unroll
            for (int ai = 0; ai < 2; ++ai)
#pragma unroll
                for (int m = 0; m < 4; ++m) { const int row = row0 + ai * HALF + m * 16; const float rs = __builtin_amdgcn_rsqf(ssq0[row] * (1.0f / 1024.0f) + 1e-6f);
                    bf16_t* rowp = z + (size_t)row * 3072 + u.pn * BM + colw;
#pragma unroll
                    for (int bj = 0; bj < 2; ++bj) *(u32x4*)(rowp + bj * HALF) = pack8(acc[ai][bj][m][0] * rs, acc[ai][bj][m][1] * rs); }
        } else {
            f32x4 bv[2][2];
#pragma unroll
            for (int bj = 0; bj < 2; ++bj)
#pragma unroll
                for (int n = 0; n < 2; ++n) bv[bj][n] = *(const f32x4*)(b_alpha + bj * HALF + colw + 4 * n);
#pragma unroll
            for (int ai = 0; ai < 2; ++ai)
#pragma unroll
                for (int m = 0; m < 4; ++m) { const int row = row0 + ai * HALF + m * 16; const float rs = __builtin_amdgcn_rsqf(ssq0[row] * (1.0f / 1024.0f) + 1e-6f);
                    float* rowp = la + (size_t)row * 256 + colw;
#pragma unroll
                    for (int bj = 0; bj < 2; ++bj)
#pragma unroll
                        for (int n = 0; n < 2; ++n) { const f32x4 v = acc[ai][bj][m][n] * rs + bv[bj][n]; f32x4 o; o[0] = logsig16(v[0]); o[1] = logsig16(v[1]); o[2] = logsig16(v[2]); o[3] = logsig16(v[3]);
                            *(f32x4*)(rowp + bj * HALF + 4 * n) = o; } }
        }
    }
};
struct EpiBf {
    static constexpr bool PERM = true, AFTER_DRAIN = false;
    bf16_t* O; int ldc;
    __device__ __forceinline__ void operator()(f32x4 (&acc)[2][2][4][2], const Unit& u, int wr, int wc, int fr, int fq, PG8_LAS unsigned char*, int) const {
        const int row0 = u.pm * BM + wr * 64 + fr, col0 = u.pn * BM + wc * 32 + 8 * fq;
#pragma unroll
        for (int ai = 0; ai < 2; ++ai)
#pragma unroll
            for (int m = 0; m < 4; ++m) { bf16_t* rowp = O + (size_t)(row0 + ai * HALF + m * 16) * ldc + col0;
#pragma unroll
                for (int bj = 0; bj < 2; ++bj) *(u32x4*)(rowp + bj * HALF) = pack8(acc[ai][bj][m][0], acc[ai][bj][m][1]); }
    }
};
template <int MODE> struct EpiRes {
    static constexpr bool PERM = true, AFTER_DRAIN = false;
    const float* base; float* out; bf16_t* hb; float* ssq_out; const float* ssq_in; const bf16_t* pp;
    __device__ __forceinline__ void operator()(f32x4 (&acc)[2][2][4][2], const Unit& u, int wr, int wc, int fr, int fq, PG8_LAS unsigned char* les, int tid) const {
        const int rowt = wr * 64 + fr, col0 = u.pn * BM + wc * 32 + 8 * fq;
        PG8_LAS float* red = (PG8_LAS float*)les;
#pragma unroll
        for (int ai = 0; ai < 2; ++ai)
#pragma unroll
            for (int m = 0; m < 4; ++m) { const int rt = rowt + ai * HALF + m * 16; const size_t off = (size_t)(u.pm * BM + rt) * 1024 + col0;
                float rs = 1.f; if (MODE == 1) rs = rstd_sum4(ssq_in + (size_t)(u.pm * BM + rt) * 4);
                float sq = 0.f;
#pragma unroll
                for (int bj = 0; bj < 2; ++bj) { f32x4 v0 = *(const f32x4*)(base + off + bj * HALF), v1 = *(const f32x4*)(base + off + bj * HALF + 4);
                    if (MODE == 0) { v0 += acc[ai][bj][m][0]; v1 += acc[ai][bj][m][1]; }
                    else { const u32x4 pw = *(const u32x4*)(pp + off + bj * HALF); const f32x4 a0 = acc[ai][bj][m][0] * rs, a1 = acc[ai][bj][m][1] * rs;
                        v0[0] += fast_sigmoid(a0[0]) * __builtin_bit_cast(float, pw.x << 16); v0[1] += fast_sigmoid(a0[1]) * __builtin_bit_cast(float, pw.x & 0xffff0000u);
                        v0[2] += fast_sigmoid(a0[2]) * __builtin_bit_cast(float, pw.y << 16); v0[3] += fast_sigmoid(a0[3]) * __builtin_bit_cast(float, pw.y & 0xffff0000u);
                        v1[0] += fast_sigmoid(a1[0]) * __builtin_bit_cast(float, pw.z << 16); v1[1] += fast_sigmoid(a1[1]) * __builtin_bit_cast(float, pw.z & 0xffff0000u);
                        v1[2] += fast_sigmoid(a1[2]) * __builtin_bit_cast(float, pw.w << 16); v1[3] += fast_sigmoid(a1[3]) * __builtin_bit_cast(float, pw.w & 0xffff0000u); }
                    *(f32x4*)(out + off + bj * HALF) = v0; *(f32x4*)(out + off + bj * HALF + 4) = v1;
                    if (hb) *(u32x4*)(hb + off + bj * HALF) = pack8(v0, v1);
                    sq += (v0[0] * v0[0] + v0[1] * v0[1]) + (v0[2] * v0[2] + v0[3] * v0[3]) + (v1[0] * v1[0] + v1[1] * v1[1]) + (v1[2] * v1[2] + v1[3] * v1[3]); }
                sq += __shfl_xor(sq, 16); sq += __shfl_xor(sq, 32);
                if (fq == 0) red[rt * 4 + wc] = sq; }
        asm volatile("s_waitcnt lgkmcnt(0)" ::: "memory"); __builtin_amdgcn_s_barrier(); asm volatile("" ::: "memory");
        if (tid < 256) { const f32x4 r = *(const PG8_LAS f32x4*)(red + tid * 4); ssq_out[(size_t)(u.pm * BM + tid) * 4 + u.pn] = (r[0] + r[1]) + (r[2] + r[3]); }
    }
};
__device__ __forceinline__ float dpp_shr1(float old, float src) { return __builtin_bit_cast(float, __builtin_amdgcn_update_dpp(__builtin_bit_cast(int, old), __builtin_bit_cast(int, src), 0x111, 0xf, 0xf, false)); }
__device__ __forceinline__ float dpp_shr2(float old, float src) { return __builtin_bit_cast(float, __builtin_amdgcn_update_dpp(__builtin_bit_cast(int, old), __builtin_bit_cast(int, src), 0x112, 0xf, 0xf, false)); }
__device__ __forceinline__ float dpp_ror1(float src) { return __builtin_bit_cast(float, __builtin_amdgcn_update_dpp(0, __builtin_bit_cast(int, src), 0x121, 0xf, 0xf, false)); }
__device__ __forceinline__ float dpp_ror2(float src) { return __builtin_bit_cast(float, __builtin_amdgcn_update_dpp(0, __builtin_bit_cast(int, src), 0x122, 0xf, 0xf, false)); }
struct EpiUp {
    static constexpr bool PERM = true, AFTER_DRAIN = false;
    const float* ssq1p; const float* cw; bf16_t* act; float* ghead; float* uhead; float* gtail;
    __device__ __forceinline__ void operator()(f32x4 (&acc)[2][2][4][2], const Unit& u, int wr, int wc, int fr, int fq, PG8_LAS unsigned char* les, int) const {
        constexpr int FF = 2816;
        const int rowt = wr * 64 + fr, cw0 = wc * 32 + 8 * fq, gc0 = u.pn * HALF + cw0;
        PG8_LAS float* H = (PG8_LAS float*)les;
#pragma unroll
        for (int ai = 0; ai < 2; ++ai)
#pragma unroll
            for (int m = 0; m < 4; ++m) { const float rs = rstd_sum4(ssq1p + (size_t)(u.pm * BM + rowt + ai * HALF + m * 16) * 4);
#pragma unroll
                for (int bj = 0; bj < 2; ++bj)
#pragma unroll
                    for (int n = 0; n < 2; ++n) acc[ai][bj][m][n] *= rs; }
        if (fr >= 14) {
#pragma unroll
            for (int ai = 0; ai < 2; ++ai)
#pragma unroll
                for (int n = 0; n < 2; ++n) *(PG8_LAS f32x4*)(H + ((ai * 2 + wr) * 2 + (fr - 14)) * HALF + cw0 + 4 * n) = acc[ai][0][3][n];
            if (wr == 1) {
#pragma unroll
                for (int n = 0; n < 2; ++n) *(f32x4*)(gtail + (size_t)(u.pm * 2 + (fr - 14)) * FF + gc0 + 4 * n) = acc[1][0][3][n]; }
        }
        if (wr == 0 && fr < 2) {
#pragma unroll
            for (int n = 0; n < 2; ++n) { *(f32x4*)(ghead + (size_t)(u.pm * 2 + fr) * FF + gc0 + 4 * n) = acc[0][0][0][n]; *(f32x4*)(uhead + (size_t)(u.pm * 2 + fr) * FF + gc0 + 4 * n) = acc[0][1][0][n]; }
        }
        asm volatile("s_waitcnt lgkmcnt(0)" ::: "memory"); __builtin_amdgcn_s_barrier(); asm volatile("" ::: "memory");
        f32x4 w0[2], w1[2], w2[2];
#pragma unroll
        for (int n = 0; n < 2; ++n) { w0[n] = *(const f32x4*)(cw + gc0 + 4 * n); w1[n] = *(const f32x4*)(cw + FF + gc0 + 4 * n); w2[n] = *(const f32x4*)(cw + 2 * FF + gc0 + 4 * n); }
#pragma unroll
        for (int ai = 0; ai < 2; ++ai) {
            f32x4 hm1[2], hm2[2];
            if (ai == 0 && wr == 0) { hm1[0] = hm1[1] = hm2[0] = hm2[1] = (f32x4){0.f, 0.f, 0.f, 0.f}; }
            else { const int s = (wr == 1) ? (ai * 2) : ((ai - 1) * 2 + 1);
#pragma unroll
                for (int n = 0; n < 2; ++n) { hm2[n] = *(const PG8_LAS f32x4*)(H + (s * 2 + 0) * HALF + cw0 + 4 * n); hm1[n] = *(const PG8_LAS f32x4*)(H + (s * 2 + 1) * HALF + cw0 + 4 * n); } }
#pragma unroll
            for (int m = 0; m < 4; ++m) {
                f32x4 a[2];
#pragma unroll
                for (int n = 0; n < 2; ++n)
#pragma unroll
                    for (int e = 0; e < 4; ++e) {
                        const float g = acc[ai][0][m][n][e];
                        float o1, o2;
                        if (m == 0) { o1 = hm1[n][e]; o2 = (fr == 0) ? hm2[n][e] : hm1[n][e]; }
                        else { const float gp = acc[ai][0][m - 1][n][e]; o1 = dpp_ror1(gp); o2 = dpp_ror2(gp); }
                        const float gm1 = dpp_shr1(o1, g), gm2 = dpp_shr2(o2, g);
                        const float cv = w2[n][e] * g + w1[n][e] * gm1 + w0[n][e] * gm2;
                        a[n][e] = cv * fast_sigmoid(cv) * acc[ai][1][m][n][e];
                    }
                *(u32x4*)(act + (size_t)(u.pm * BM + rowt + ai * HALF + m * 16) * FF + gc0) = pack8(a[0], a[1]);
            }
        }
    }
};
template <class Epi, class Sched, bool ALIGN_EPI = false, bool SP2 = false>
__device__ __forceinline__ void gemm_phase(PG8_LAS unsigned char* lds, const Gemm g, const Sched& S, const Epi& E) {
    const int tid = threadIdx.x, wid = __builtin_amdgcn_readfirstlane(tid >> 6), lane = tid & 63, wr = wid >> 2, wc = wid & 3, fr = lane & 15, fq = lane >> 4;
    const int K = g.K, nt = K / BK;
    unsigned voffA[2], voffB[2];
#pragma unroll
    for (int i = 0; i < 2; ++i) { int R, C; stage_rc(tid * 16 + i * 8192, R, C); const int Rb = Epi::PERM ? ((R & ~31) + perm32(R & 31)) : R;
        voffA[i] = (unsigned)(R * K + C) * 2u; voffB[i] = (unsigned)(Rb * K + C) * 2u; }
    const size_t kstep = (size_t)(BK * 2);
    const size_t hstep = (size_t)HALF * K * 2;
    const size_t tstep = 2 * hstep;
    const unsigned ldsw = (unsigned)wid * 1024u;
    const int aoff = lds_byte(wr * 64 + fr, fq * 8), boff = lds_byte(wc * 32 + fr, fq * 8);
#define PG8_SA(b, h) (((b) * 2 + (h)) * HTB)
#define PG8_SB(b, h) ((4 + (b) * 2 + (h)) * HTB)
#define PG8_STAGE(bufoff, gbase, voff) do { _Pragma("unroll") for (int _i = 0; _i < 2; ++_i) \
        __builtin_amdgcn_global_load_lds((const unsigned*)((const char*)(gbase) + (voff)[_i]), (PG8_LAS unsigned*)(lds + (bufoff) + ldsw + _i * 8192), 16, 0, 0); } while (0)
#define PG8_LDA(dst, b, h) do { _Pragma("unroll") for (int m = 0; m < 4; ++m) _Pragma("unroll") for (int k = 0; k < 2; ++k) dst[m][k] = *(const PG8_LAS bf16x8*)(lds + PG8_SA(b, h) + aoff + m * 2048 + k * 1024); } while (0)
#define PG8_LDB(dst, b, h) do { _Pragma("unroll") for (int n = 0; n < 2; ++n) _Pragma("unroll") for (int k = 0; k < 2; ++k) dst[n][k] = *(const PG8_LAS bf16x8*)(lds + PG8_SB(b, h) + boff + n * 2048 + k * 1024); } while (0)
#define PG8_MMA(ai, bj, At, Bt) do { __builtin_amdgcn_s_setprio(1); _Pragma("unroll") for (int m = 0; m < 4; ++m) _Pragma("unroll") for (int n = 0; n < 2; ++n) _Pragma("unroll") for (int k = 0; k < 2; ++k) \
        acc[ai][bj][m][n] = __builtin_amdgcn_mfma_f32_16x16x32_bf16(Bt[n][k], At[m][k], acc[ai][bj][m][n], 0, 0, 0); __builtin_amdgcn_s_setprio(0); } while (0)
#define PG8_WAIT_V(n) asm volatile("s_waitcnt vmcnt(" #n ")" ::: "memory")
#define PG8_WAIT_L(n) asm volatile("s_waitcnt lgkmcnt(" #n ")" ::: "memory")
#define PG8_BAR __builtin_amdgcn_s_barrier()
#define PG8_SCHED __builtin_amdgcn_sched_barrier(0)
    Unit cur, nxt; int ui = 0;
    if (!S.next(0, cur)) return;
    f32x4 acc[2][2][4][2];
#pragma unroll
    for (int a = 0; a < 2; ++a)
#pragma unroll
        for (int b = 0; b < 2; ++b)
#pragma unroll
            for (int m = 0; m < 4; ++m)
#pragma unroll
                for (int n = 0; n < 2; ++n) acc[a][b][m][n] = (f32x4){0.f, 0.f, 0.f, 0.f};
    bf16x8 At[4][2], B0[2][2], B1[2][2];
    const char* cA = (const char*)g.A + (size_t)cur.pm * tstep; const char* cB = (const char*)g.Bt + (size_t)cur.pn * tstep;
    S.a_ready(cur);
    if constexpr (SP2) {
        PG8_STAGE(PG8_SB(0, 0), cB, voffB); PG8_STAGE(PG8_SB(0, 1), cB + hstep, voffB); PG8_STAGE(PG8_SA(0, 0), cA, voffA); PG8_STAGE(PG8_SA(0, 1), cA + hstep, voffA);
        if (wr == 1) PG8_BAR;
        PG8_WAIT_V(2); PG8_BAR;
        PG8_STAGE(PG8_SB(1, 0), cB + kstep, voffB); PG8_STAGE(PG8_SA(1, 0), cA + kstep, voffA); PG8_STAGE(PG8_SB(1, 1), cB + hstep + kstep, voffB);
        PG8_WAIT_V(6); PG8_BAR;
    } else {
        PG8_STAGE(PG8_SB(0, 0), cB, voffB); PG8_STAGE(PG8_SA(0, 0), cA, voffA); PG8_STAGE(PG8_SB(0, 1), cB + hstep, voffB); PG8_STAGE(PG8_SA(0, 1), cA + hstep, voffA);
        if (wr == 1) PG8_BAR;
        PG8_WAIT_V(4); PG8_BAR;
        PG8_STAGE(PG8_SB(1, 0), cB + kstep, voffB); PG8_STAGE(PG8_SA(1, 0), cA + kstep, voffA); PG8_STAGE(PG8_SB(1, 1), cB + hstep + kstep, voffB);
        PG8_WAIT_V(6); PG8_BAR;
    }
    for (;;) {
        const bool has_next = S.next(ui + 1, nxt);
        const char* nA = has_next ? (const char*)g.A + (size_t)nxt.pm * tstep : cA; const char* nB = has_next ? (const char*)g.Bt + (size_t)nxt.pn * tstep : cB;
        for (int t = 0; t < nt; t += 2) {
            const bool last = (t == nt - 2);
            const char* a1 = cA + (size_t)(t + 1) * kstep;
            const char* a2 = last ? nA : cA + (size_t)(t + 2) * kstep; const char* b2 = last ? nB : cB + (size_t)(t + 2) * kstep;
            const char* a3 = a2 + kstep; const char* b3 = b2 + kstep;
            if (last && has_next) S.a_ready(nxt);
            if constexpr (SP2) {
            PG8_LDB(B0, 0, 0); PG8_LDB(B1, 0, 1); PG8_SCHED; PG8_LDA(At, 0, 0); PG8_STAGE(PG8_SA(1, 1), a1 + hstep, voffA);
            PG8_WAIT_V(8); PG8_WAIT_L(0); PG8_BAR; PG8_MMA(0, 0, At, B0); PG8_MMA(0, 1, At, B1); PG8_BAR; PG8_SCHED;
            PG8_LDA(At, 0, 1); PG8_STAGE(PG8_SB(0, 0), b2, voffB); PG8_STAGE(PG8_SB(0, 1), b2 + hstep, voffB); PG8_STAGE(PG8_SA(0, 0), a2, voffA);
            PG8_WAIT_V(8); PG8_WAIT_L(0); PG8_BAR; PG8_MMA(1, 0, At, B0); PG8_MMA(1, 1, At, B1); PG8_BAR; PG8_SCHED;
            PG8_LDB(B0, 1, 0); PG8_LDB(B1, 1, 1); PG8_SCHED; PG8_LDA(At, 1, 0); PG8_STAGE(PG8_SA(0, 1), a2 + hstep, voffA);
            PG8_WAIT_V(8); PG8_WAIT_L(0); PG8_BAR; PG8_MMA(0, 0, At, B0); PG8_MMA(0, 1, At, B1); PG8_BAR; PG8_SCHED;
            PG8_LDA(At, 1, 1); PG8_STAGE(PG8_SB(1, 0), b3, voffB); PG8_STAGE(PG8_SB(1, 1), b3 + hstep, voffB); PG8_STAGE(PG8_SA(1, 0), a3, voffA);
            PG8_WAIT_V(8); PG8_WAIT_L(0); PG8_BAR; PG8_MMA(1, 0, At, B0); PG8_MMA(1, 1, At, B1); PG8_BAR; PG8_SCHED;
            } else {
            PG8_LDB(B0, 0, 0); PG8_SCHED; PG8_LDA(At, 0, 0); PG8_STAGE(PG8_SA(1, 1), a1 + hstep, voffA);
            PG8_WAIT_L(8); PG8_BAR; PG8_WAIT_L(0); PG8_MMA(0, 0, At, B0); PG8_BAR; PG8_SCHED;
            PG8_LDB(B1, 0, 1); PG8_STAGE(PG8_SB(0, 0), b2, voffB);
            PG8_BAR; PG8_WAIT_L(0); PG8_MMA(0, 1, At, B1); PG8_BAR;
            PG8_LDA(At, 0, 1); PG8_STAGE(PG8_SA(0, 0), a2, voffA);
            PG8_BAR; PG8_WAIT_L(0); PG8_MMA(1, 0, At, B0); PG8_BAR; PG8_SCHED;
            PG8_STAGE(PG8_SB(0, 1), b2 + hstep, voffB);
            PG8_WAIT_V(6); PG8_BAR; PG8_MMA(1, 1, At, B1); PG8_BAR;
            PG8_LDB(B0, 1, 0); PG8_SCHED; PG8_LDA(At, 1, 0); PG8_STAGE(PG8_SA(0, 1), a2 + hstep, voffA);
            PG8_WAIT_L(8); PG8_BAR; PG8_WAIT_L(0); PG8_MMA(0, 0, At, B0); PG8_BAR; PG8_SCHED;
            PG8_LDB(B1, 1, 1); PG8_STAGE(PG8_SB(1, 0), b3, voffB);
            PG8_BAR; PG8_WAIT_L(0); PG8_MMA(0, 1, At, B1); PG8_BAR;
            PG8_LDA(At, 1, 1); PG8_STAGE(PG8_SA(1, 0), a3, voffA);
            PG8_BAR; PG8_WAIT_L(0); PG8_MMA(1, 0, At, B0); PG8_BAR; PG8_SCHED;
            PG8_STAGE(PG8_SB(1, 1), b3 + hstep, voffB);
            PG8_WAIT_V(6); PG8_BAR; PG8_MMA(1, 1, At, B1); PG8_BAR;
            }
        }
        if constexpr (ALIGN_EPI) { if (wr == 0) PG8_BAR; }
        if constexpr (!Epi::AFTER_DRAIN) { E(acc, cur, wr, wc, fr, fq, lds + STAGE_BYTES, tid); S.done(cur); }
        if (!has_next) break;
#pragma unroll
        for (int a = 0; a < 2; ++a)
#pragma unroll
            for (int b = 0; b < 2; ++b)
#pragma unroll
                for (int m = 0; m < 4; ++m)
#pragma unroll
                    for (int n = 0; n < 2; ++n) acc[a][b][m][n] = (f32x4){0.f, 0.f, 0.f, 0.f};
        cur = nxt; cA = nA; cB = nB; ++ui;
        if constexpr (ALIGN_EPI) { if (wr == 1) PG8_BAR; }
    }
    PG8_WAIT_V(0);
    if constexpr (!ALIGN_EPI) { if (wr == 0) PG8_BAR; }
    PG8_BAR;
    (void)lane;
#undef PG8_SA
#undef PG8_SB
#undef PG8_STAGE
#undef PG8_LDA
#undef PG8_LDB
#undef PG8_MMA
#undef PG8_WAIT_V
#undef PG8_WAIT_L
#undef PG8_BAR
#undef PG8_SCHED
}
}

#define LAS __attribute__((address_space(3)))
typedef unsigned v4u __attribute__((ext_vector_type(4)));
typedef unsigned v2u __attribute__((ext_vector_type(2)));
typedef float f32x4 __attribute__((ext_vector_type(4)));
typedef float f32x2 __attribute__((ext_vector_type(2)));
typedef float f32x16 __attribute__((ext_vector_type(16)));
typedef short bf16x8 __attribute__((ext_vector_type(8)));
#define LDS_FENCE() asm volatile("s_waitcnt lgkmcnt(0)" ::: "memory")
#define MFMA32(a, b, c) __builtin_amdgcn_mfma_f32_32x32x16_bf16((a), (b), (c), 0, 0, 0)
__device__ __forceinline__ unsigned pk2(float lo, float hi) { return f2bf(lo) | (f2bf(hi) << 16); }
__device__ __forceinline__ float bflo(unsigned w) { return __builtin_bit_cast(float, w << 16); }
__device__ __forceinline__ float bfhi(unsigned w) { return __builtin_bit_cast(float, w & 0xffff0000u); }
__device__ __forceinline__ int crow(int r, int h) { return (r & 3) + 8 * (r >> 2) + 4 * h; }

template <class Src> __device__ __forceinline__ void wt_item(const Src& src, int K, bf16* WT, int kb, int nb, const float* gain, LAS float* scr, int lane) {
    const int k0 = 64 * kb, n0 = 32 * nb;
#pragma unroll 8
    for (int i = 0; i < 32; ++i) { const int kk = 2 * i + (lane >> 5); float v = src(k0 + kk, n0 + (lane & 31)); if (gain) v *= gain[k0 + kk]; scr[kk * 33 + (lane & 31)] = v; }
    LDS_FENCE();
    const int c = lane & 7;
#pragma unroll
    for (int j = 0; j < 4; ++j) { const int n = (lane >> 3) + 8 * j; const LAS float* s = scr + (8 * c) * 33 + n;
        v4u o; o.x = pk2(s[0 * 33], s[1 * 33]); o.y = pk2(s[2 * 33], s[3 * 33]); o.z = pk2(s[4 * 33], s[5 * 33]); o.w = pk2(s[6 * 33], s[7 * 33]);
        *(v4u*)(WT + (size_t)(n0 + n) * K + k0 + 8 * c) = o; }
    LDS_FENCE();
}
struct SrcPlain { const float* W; int N; int mode;
    __device__ __forceinline__ float operator()(int k, int n) const { int col = n; if (mode == 1) col = n < 1536 ? n : n + 16; else if (mode == 2) { const int j = n >> 8, i = n & 255; col = i < 128 ? 128 * j + i : DFF + 128 * j + (i - 128); } return W[(size_t)k * N + col]; } };
struct SrcAlpha { const float* w_in; const float* wau;
    __device__ __forceinline__ float operator()(int k, int c) const { float s = 0.f;
#pragma unroll
        for (int r = 0; r < 16; ++r) s += w_in[(size_t)k * DIN + 1536 + r] * wau[r * 256 + c]; return s; } };
__device__ __forceinline__ float wave_sum(float v) {
#pragma unroll
    for (int o = 1; o < 64; o <<= 1) v += __shfl_xor(v, o);
    return v; }
struct ProArgs { const float *x, *p, *attn_norm, *w_in, *wau, *w_out, *ffn_norm, *w_up, *w_down, *ple_norm, *w_pg, *w_pp; bf16 *WIN, *WOUT, *WUP, *WDN, *WPG, *WPP, *xb, *pb; float* ssq0; };
__device__ __forceinline__ void phase_prologue(const ProArgs& A, LAS unsigned char* lds, int gw, int NGW, int wave, int lane) {
    LAS float* scr = (LAS float*)(lds + wave * 16384);
    constexpr int I_IN = 16 * 96, I_AL = 16 * 8, I_O = 16 * 32, I_UP = 16 * 176, I_DN = 44 * 32, I_PG = 16 * 32, I_PP = 4 * 32;
    constexpr int NITEMS = I_IN + I_AL + I_O + I_UP + I_DN + I_PG + I_PP;
    for (int it = gw; it < NITEMS; it += NGW) {
        int r = it;
        if (r < I_IN) { wt_item(SrcPlain{A.w_in, DIN, 1}, DM, A.WIN, r / 96, r % 96, A.attn_norm, scr, lane); continue; } r -= I_IN;
        if (r < I_AL) { wt_item(SrcAlpha{A.w_in, A.wau}, DM, A.WIN + (size_t)NZ * DM, r / 8, r % 8, A.attn_norm, scr, lane); continue; } r -= I_AL;
        if (r < I_O) { wt_item(SrcPlain{A.w_out, DM, 0}, DM, A.WOUT, r / 32, r % 32, nullptr, scr, lane); continue; } r -= I_O;
        if (r < I_UP) { wt_item(SrcPlain{A.w_up, NUP, 2}, DM, A.WUP, r / 176, r % 176, A.ffn_norm, scr, lane); continue; } r -= I_UP;
        if (r < I_DN) { wt_item(SrcPlain{A.w_down, DM, 0}, DFF, A.WDN, r / 32, r % 32, nullptr, scr, lane); continue; } r -= I_DN;
        if (r < I_PG) { wt_item(SrcPlain{A.w_pg, DM, 0}, DM, A.WPG, r / 32, r % 32, A.ple_norm, scr, lane); continue; } r -= I_PG;
        wt_item(SrcPlain{A.w_pp, DM, 0}, PLE, A.WPP, r / 32, r % 32, nullptr, scr, lane);
    }
    for (int m = gw; m < T; m += NGW) {
        const f32x4* xr = (const f32x4*)(A.x + (size_t)m * DM) + lane; unsigned long long* o8 = (unsigned long long*)(A.xb + (size_t)m * DM) + lane;
        f32x4 v[4]; float s = 0.f;
#pragma unroll
        for (int j = 0; j < 4; ++j) { v[j] = xr[64 * j]; s += (v[j][0] * v[j][0] + v[j][1] * v[j][1]) + (v[j][2] * v[j][2] + v[j][3] * v[j][3]); }
#pragma unroll
        for (int j = 0; j < 4; ++j) o8[64 * j] = (unsigned long long)pk2(v[j][0], v[j][1]) | ((unsigned long long)pk2(v[j][2], v[j][3]) << 32);
        s = wave_sum(s); if (lane == 0) A.ssq0[m] = s;
        const f32x4 pv = ((const f32x4*)(A.p + (size_t)m * PLE))[lane];
        ((unsigned long long*)(A.pb + (size_t)m * PLE))[lane] = (unsigned long long)pk2(pv[0], pv[1]) | ((unsigned long long)pk2(pv[2], pv[3]) << 32);
    }
}

constexpr int IMG_STRIDE = 144, IMG_BYTES = 64 * IMG_STRIDE, WAVE_LDS = 2 * IMG_BYTES;
__device__ __forceinline__ bf16x8 img_frag(const LAS unsigned char* img, int row, int s, int hh) { return *(const LAS bf16x8*)(img + row * IMG_STRIDE + (16 * s + 8 * hh) * 2); }
__device__ __forceinline__ f32x16 zero16() { f32x16 z; for (int i = 0; i < 16; ++i) z[i] = 0.f; return z; }

__device__ __forceinline__ void load_vt_half(LAS unsigned char* img, const bf16* __restrict__ vp, int lane) {
#pragma unroll 4
    for (int t8 = 0; t8 < 8; ++t8) { unsigned e[8];
#pragma unroll
        for (int j = 0; j < 8; ++j) e[j] = vp[(size_t)(t8 * 8 + j) * NZ];
        v4u w; w.x = e[0] | (e[1] << 16); w.y = e[2] | (e[3] << 16); w.z = e[4] | (e[5] << 16); w.w = e[6] | (e[7] << 16);
        *(LAS v4u*)(img + lane * IMG_STRIDE + t8 * 16) = w; }
}
__device__ __forceinline__ void gla_a1(LAS unsigned char* wl, int task, const bf16* __restrict__ z, const float* __restrict__ la, float* __restrict__ U, float* __restrict__ decay, int lane) {
    const int bh = task >> 7, n = task & 127, b = bh >> 2, h = bh & 3, hh = lane >> 5, l31 = lane & 31;
    const size_t t0 = (size_t)b * SEQ + (size_t)n * 64;
    LAS unsigned char* ket = wl; LAS unsigned char* vt = wl + IMG_BYTES;
    const float* lp = la + t0 * 256 + h * 64 + lane;
    float bl = 0.f;
#pragma unroll 16
    for (int t = 0; t < 64; ++t) bl += lp[(size_t)t * 256];
    decay[(size_t)task * 64 + lane] = __expf(bl);
    { const bf16* kp = z + t0 * NZ + ZK + h * 64 + lane; float s = 0.f;
#pragma unroll 2
      for (int t8 = 0; t8 < 8; ++t8) { float e[8];
#pragma unroll
          for (int j = 0; j < 8; ++j) { s += lp[(size_t)(t8 * 8 + j) * 256]; e[j] = bf2f(kp[(size_t)(t8 * 8 + j) * NZ]) * __expf(bl - s); }
          v4u w; w.x = pk2(e[0], e[1]); w.y = pk2(e[2], e[3]); w.z = pk2(e[4], e[5]); w.w = pk2(e[6], e[7]);
          *(LAS v4u*)(ket + lane * IMG_STRIDE + t8 * 16) = w; } }
#pragma unroll 4
    for (int hv = 0; hv < 2; ++hv) {
        load_vt_half(vt, z + t0 * NZ + ZV + h * 128 + hv * 64 + lane, lane);
        LDS_FENCE();
        f32x16 acc[2][2];
#pragma unroll
        for (int tv = 0; tv < 2; ++tv)
#pragma unroll
            for (int td = 0; td < 2; ++td) acc[tv][td] = zero16();
#pragma unroll
        for (int s = 0; s < 4; ++s) { bf16x8 af[2], bfr[2];
#pragma unroll
            for (int q = 0; q < 2; ++q) { af[q] = img_frag(vt, 32 * q + l31, s, hh); bfr[q] = img_frag(ket, 32 * q + l31, s, hh); }
#pragma unroll
            for (int tv = 0; tv < 2; ++tv)
#pragma unroll
                for (int td = 0; td < 2; ++td) acc[tv][td] = MFMA32(af[tv], bfr[td], acc[tv][td]); }
        float* up = U + (size_t)task * 8192 + (size_t)hv * 64 * 64;
#pragma unroll
        for (int tv = 0; tv < 2; ++tv)
#pragma unroll
            for (int td = 0; td < 2; ++td)
#pragma unroll
                for (int r = 0; r < 16; ++r) up[(32 * tv + crow(r, hh)) * 64 + 32 * td + l31] = acc[tv][td][r];
        LDS_FENCE();
    }
}
__device__ __forceinline__ void gla_scan(const float* __restrict__ U, const float* __restrict__ decay, bf16* __restrict__ Sp, int gtid, int gthreads) {
    for (int item = gtid; item < 16 * 4096; item += gthreads) {
        const int bh = item >> 12, e2 = (item & 4095) * 2, d = e2 & 63;
        const float* up = U + (size_t)bh * 128 * 8192 + e2; const float* dp = decay + (size_t)bh * 128 * 64 + d; bf16* sp = Sp + (size_t)bh * 128 * 8192 + e2;
        float s0 = 0.f, s1 = 0.f;
#pragma unroll 8
        for (int n = 0; n < 128; ++n) { const f32x2 u = *(const f32x2*)(up + (size_t)n * 8192); const f32x2 dc = *(const f32x2*)(dp + n * 64);
            *(unsigned*)(sp + (size_t)n * 8192) = pk2(s0, s1); s0 = dc[0] * s0 + u[0]; s1 = dc[1] * s1 + u[1]; }
    }
}
__device__ __forceinline__ void conv_mix(const bf16* __restrict__ z, const float* __restrict__ cw, bf16* __restrict__ mix, int gw, int NGW, int lane) {
    const int c0 = lane * 8;
    float w0[8], w1[8], w2[8];
#pragma unroll
    for (int j = 0; j < 8; ++j) { w0[j] = cw[c0 + j]; w1[j] = cw[512 + c0 + j]; w2[j] = cw[1024 + c0 + j]; }
    for (int run = gw; run < T / 16; run += NGW) {
        const size_t tf = (size_t)run * 16; const bool has_prev = (tf % SEQ) != 0;
        float um2[8], um1[8];
#pragma unroll
        for (int j = 0; j < 8; ++j) { um2[j] = 0.f; um1[j] = 0.f; }
        if (has_prev) {
            const v4u c2 = *(const v4u*)(z + (tf - 2) * NZ + ZCC + c0), x2 = *(const v4u*)(z + (tf - 2) * NZ + ZCX + c0), c1 = *(const v4u*)(z + (tf - 1) * NZ + ZCC + c0), x1 = *(const v4u*)(z + (tf - 1) * NZ + ZCX + c0);
#pragma unroll
            for (int q = 0; q < 4; ++q) { um2[2 * q] = bflo(c2[q]) * bflo(x2[q]); um2[2 * q + 1] = bfhi(c2[q]) * bfhi(x2[q]); um1[2 * q] = bflo(c1[q]) * bflo(x1[q]); um1[2 * q + 1] = bfhi(c1[q]) * bfhi(x1[q]); }
        }
#pragma unroll 4
        for (int t = 0; t < 16; ++t) { const size_t row = tf + t;
            const v4u cb = *(const v4u*)(z + row * NZ + ZCB + c0), cc = *(const v4u*)(z + row * NZ + ZCC + c0), cx = *(const v4u*)(z + row * NZ + ZCX + c0);
            float u[8], o[8];
#pragma unroll
            for (int q = 0; q < 4; ++q) { u[2 * q] = bflo(cc[q]) * bflo(cx[q]); u[2 * q + 1] = bfhi(cc[q]) * bfhi(cx[q]); }
#pragma unroll
            for (int q = 0; q < 4; ++q) { o[2 * q] = bflo(cb[q]) * (w0[2 * q] * um2[2 * q] + w1[2 * q] * um1[2 * q] + w2[2 * q] * u[2 * q]);
                o[2 * q + 1] = bfhi(cb[q]) * (w0[2 * q + 1] * um2[2 * q + 1] + w1[2 * q + 1] * um1[2 * q + 1] + w2[2 * q + 1] * u[2 * q + 1]); }
            v4u w; w.x = pk2(o[0], o[1]); w.y = pk2(o[2], o[3]); w.z = pk2(o[4], o[5]); w.w = pk2(o[6], o[7]);
            *(v4u*)(mix + row * DM + 512 + c0) = w;
#pragma unroll
            for (int j = 0; j < 8; ++j) { um2[j] = um1[j]; um1[j] = u[j]; } }
    }
}
__device__ __forceinline__ bf16x8 pack_step(const f32x16& x, int s) { v4u p; p.x = pk2(x[8 * s], x[8 * s + 1]); p.y = pk2(x[8 * s + 2], x[8 * s + 3]); p.z = pk2(x[8 * s + 4], x[8 * s + 5]); p.w = pk2(x[8 * s + 6], x[8 * s + 7]); return __builtin_bit_cast(bf16x8, p); }
__device__ __forceinline__ bf16x8 img_frag_perm(const LAS unsigned char* img, int row, int s, int hh) {
    const v2u lo = *(const LAS v2u*)(img + row * IMG_STRIDE + (16 * s + 4 * hh) * 2), hi = *(const LAS v2u*)(img + row * IMG_STRIDE + (16 * s + 8 + 4 * hh) * 2);
    v4u w; w.x = lo.x; w.y = lo.y; w.z = hi.x; w.w = hi.y; return __builtin_bit_cast(bf16x8, w); }
__device__ __forceinline__ void gla_a3(LAS unsigned char* wl, int task, const bf16* __restrict__ z, const float* __restrict__ la, const bf16* __restrict__ Sp, const float* __restrict__ hn, bf16* __restrict__ mix, int lane) {
    const int bh = task >> 7, n = task & 127, b = bh >> 2, h = bh & 3, hh = lane >> 5, l31 = lane & 31;
    const size_t t0 = (size_t)b * SEQ + (size_t)n * 64;
    LAS unsigned char* r0 = wl;
    LAS unsigned char* r1 = wl + IMG_BYTES;
    { float s = 0.f; const float* lp = la + t0 * 256 + h * 64 + lane; const bf16* qp = z + t0 * NZ + ZQ + h * 64 + lane; const bf16* kp = z + t0 * NZ + ZK + h * 64 + lane;
#pragma unroll 8
      for (int t = 0; t < 64; ++t) { s += lp[(size_t)t * 256];
          const float qd = bf2f(qp[(size_t)t * NZ]) * 0.125f * __expf(s), kd = bf2f(kp[(size_t)t * NZ]) * __expf(-s);
          *(LAS unsigned short*)(r1 + t * IMG_STRIDE + lane * 2) = (unsigned short)f2bf(qd); *(LAS unsigned short*)(r0 + t * IMG_STRIDE + lane * 2) = (unsigned short)f2bf(kd); } }
    LDS_FENCE();
    bf16x8 qf[2][4], pf0[2], pf1[4];
    {
        f32x16 x00 = zero16(), x01 = zero16(), x11 = zero16();
#pragma unroll
        for (int ti = 0; ti < 2; ++ti)
#pragma unroll
            for (int s = 0; s < 4; ++s) qf[ti][s] = img_frag(r1, 32 * ti + l31, s, hh);
#pragma unroll
        for (int s = 0; s < 4; ++s) { const bf16x8 k0 = img_frag(r0, l31, s, hh), k1 = img_frag(r0, 32 + l31, s, hh);
            x00 = MFMA32(k0, qf[0][s], x00); x01 = MFMA32(k0, qf[1][s], x01); x11 = MFMA32(k1, qf[1][s], x11); }
#pragma unroll
        for (int r = 0; r < 16; ++r) if (crow(r, hh) > l31) { x00[r] = 0.f; x11[r] = 0.f; }
        pf0[0] = pack_step(x00, 0); pf0[1] = pack_step(x00, 1);
        pf1[0] = pack_step(x01, 0); pf1[1] = pack_step(x01, 1); pf1[2] = pack_step(x11, 0); pf1[3] = pack_step(x11, 1);
    }
    LDS_FENCE();
    load_vt_half(r0, z + t0 * NZ + ZV + h * 128 + lane, lane);
    load_vt_half(r1, z + t0 * NZ + ZV + h * 128 + 64 + lane, lane);
    LDS_FENCE();
#pragma unroll
    for (int ti = 0; ti < 2; ++ti) {
        unsigned opq = 0; asm volatile("" : "+v"(opq));
        f32x16 o[2][2];
#pragma unroll
        for (int hv = 0; hv < 2; ++hv)
#pragma unroll
            for (int tv = 0; tv < 2; ++tv) {
                asm volatile("" ::: "memory"); f32x16 acc = zero16(); const LAS unsigned char* img = (hv ? r1 : r0) + opq;
#pragma unroll
                for (int s = 0; s < 4; ++s) { if (ti == 0 && s >= 2) continue;
                    acc = MFMA32(img_frag_perm(img, 32 * tv + l31, s, hh), ti == 0 ? pf0[s & 1] : pf1[s], acc); }
                const bf16* sp = Sp + (size_t)task * 8192 + (size_t)(hv * 64 + 32 * tv + l31) * 64 + 8 * hh + opq;
#pragma unroll
                for (int s = 0; s < 4; ++s) acc = MFMA32(*(const bf16x8*)(sp + 16 * s), qf[ti][s], acc);
                o[hv][tv] = acc; }
        float ss = 0.f;
#pragma unroll
        for (int hv = 0; hv < 2; ++hv)
#pragma unroll
            for (int tv = 0; tv < 2; ++tv)
#pragma unroll
                for (int r = 0; r < 16; ++r) ss += o[hv][tv][r] * o[hv][tv][r];
        ss += __shfl_xor(ss, 32);
        const float rs = rsqrtf(ss * (1.0f / 128.0f) + EPS);
        const size_t row = t0 + 32 * ti + l31;
#pragma unroll
        for (int hv = 0; hv < 2; ++hv)
#pragma unroll
            for (int tv = 0; tv < 2; ++tv)
#pragma unroll
                for (int g = 0; g < 4; ++g) { const int v0 = hv * 64 + 32 * tv + 8 * g + 4 * hh;
                    v2u gw = *(const v2u*)(z + row * NZ + ZG + h * 128 + v0); const f32x4 gn = *(const f32x4*)(hn + h * 128 + v0);
                    asm volatile("" : "+v"(gw.x), "+v"(gw.y) : "v"(rs));
                    const float g0 = bflo(gw.x), g1 = bfhi(gw.x), g2 = bflo(gw.y), g3 = bfhi(gw.y);
                    v2u w; w.x = pk2(o[hv][tv][4 * g] * rs * gn[0] * siluf_(g0), o[hv][tv][4 * g + 1] * rs * gn[1] * siluf_(g1));
                    w.y = pk2(o[hv][tv][4 * g + 2] * rs * gn[2] * siluf_(g2), o[hv][tv][4 * g + 3] * rs * gn[3] * siluf_(g3));
                    *(v2u*)(mix + row * DM + h * 128 + v0) = w;
                    if (g & 1) asm volatile("" ::: "memory"); }
        __builtin_amdgcn_sched_barrier(0);
    }
}
__device__ __forceinline__ void fixup_phase(const float* __restrict__ ghead, const float* __restrict__ uhead, const float* __restrict__ gtail, const float* __restrict__ cw, bf16* __restrict__ act, int gtid, int gthreads) {
    for (int idx = gtid; idx < 128 * 2 * DFF; idx += gthreads) {
        const int pm = idx / (2 * DFF), j = (idx / DFF) & 1, c = idx % DFF;
        if ((pm & 31) == 0) continue;
        const float g0 = ghead[(size_t)(pm * 2 + j) * DFF + c];
        const float t1 = gtail[(size_t)((pm - 1) * 2 + 1) * DFF + c], t0 = gtail[(size_t)((pm - 1) * 2) * DFF + c];
        const float gm1 = j ? ghead[(size_t)(pm * 2) * DFF + c] : t1, gm2 = j ? t1 : t0;
        const float cv = cw[2 * DFF + c] * g0 + cw[DFF + c] * gm1 + cw[c] * gm2;
        act[(size_t)(pm * 256 + j) * DFF + c] = (bf16)f2bf(siluf_(cv) * uhead[(size_t)(pm * 2 + j) * DFF + c]);
    }
}
__device__ __forceinline__ void final_phase(float* __restrict__ hio, const float* __restrict__ ssq3p, const float* __restrict__ fn, int gw, int NGW, int lane) {
    f32x4 g[4];
#pragma unroll
    for (int j = 0; j < 4; ++j) g[j] = ((const f32x4*)fn)[lane + 64 * j];
    for (int m = gw; m < T; m += NGW) { const f32x4 sq = *(const f32x4*)(ssq3p + (size_t)m * 4); const float rs = rsqrtf(((sq[0] + sq[1]) + (sq[2] + sq[3])) * (1.0f / DM) + EPS);
        f32x4* hr = (f32x4*)(hio + (size_t)m * DM) + lane;
#pragma unroll
        for (int j = 0; j < 4; ++j) hr[64 * j] = hr[64 * j] * rs * g[j]; }
}
#define XB_TMO      128
#define XB_XCNT(j)  (256  + 64 * (j))
#define XB_XSUB(j)  (1280 + 64 * (j))
#define XB_XGEN(j)  (2304 + 64 * (j))
#define XB_TOP      3328
#define XB_TOPGEN   3392
#define XCD_BAR_WORDS 3456
#define XB_SPIN_CAP (1u << 18)

__device__ __forceinline__ unsigned xb_ld(unsigned* p)              { return __hip_atomic_load(p, __ATOMIC_RELAXED, __HIP_MEMORY_SCOPE_AGENT); }
__device__ __forceinline__ unsigned xb_add(unsigned* p, unsigned v) { return __hip_atomic_fetch_add(p, v, __ATOMIC_RELAXED, __HIP_MEMORY_SCOPE_AGENT); }
__device__ __forceinline__ unsigned xb_xcc_id() { return (unsigned)__builtin_amdgcn_s_getreg((3 << 11) | 20) & 0xFu; }
#define XB_SPIN(cond, bar) do { unsigned _sp = 0; while (cond) { __builtin_amdgcn_s_sleep(1); \
    if ((++_sp & 255u) == 0u) { if (xb_ld(&(bar)[XB_TMO])) break; if (_sp > XB_SPIN_CAP) { atomicAdd(&(bar)[XB_TMO], 1u); break; } } } } while (0)

struct XcdBarrier {
    unsigned* bar; unsigned x;
    volatile LAS unsigned* st;
};

__device__ __forceinline__ XcdBarrier xcd_barrier_post(unsigned* bar, volatile LAS unsigned* st) {
    XcdBarrier b; b.bar = bar; b.x = xb_xcc_id(); b.st = st;
    if (threadIdx.x == 0) (void)xb_add(&bar[XB_XCNT(b.x)], 1u);
    return b;
}
__device__ __forceinline__ void xcd_barrier_complete(unsigned* bar, unsigned x, unsigned& nloc, unsigned& nx) {
    const unsigned G = gridDim.x * gridDim.y * gridDim.z;
    unsigned sum, cnt, mine, sp = 0u;
    for (;;) {
        sum = 0u; cnt = 0u; mine = 0u;
#pragma unroll
        for (unsigned j = 0; j < 16; ++j) { const unsigned c = xb_ld(&bar[XB_XCNT(j)]); sum += c; cnt += (c > 0u) ? 1u : 0u; mine = (j == x) ? c : mine; }
        if (sum == G) break;
        __builtin_amdgcn_s_sleep(1);
        if ((++sp & 255u) == 0u) { if (xb_ld(&bar[XB_TMO])) break; if (sp > XB_SPIN_CAP) { atomicAdd(&bar[XB_TMO], 1u); break; } }
    }
    nloc = mine > 0u ? mine : 1u; nx = cnt > 0u ? cnt : 1u;
}

__device__ __forceinline__ void xcd_barrier(const XcdBarrier& b) {
    asm volatile("s_waitcnt vmcnt(0)" ::: "memory");
    __syncthreads();
    if (threadIdx.x == 0) {
        unsigned* bar = b.bar;
        __builtin_amdgcn_s_waitcnt(0);
        unsigned nloc = b.st[0], nx = b.st[1];
        if (nloc == 0u) { xcd_barrier_complete(bar, b.x, nloc, nx); b.st[0] = nloc; b.st[1] = nx; }
        const unsigned old = xb_add(&bar[XB_XSUB(b.x)], 1u);
        const unsigned gen = old / nloc;
        if (old + 1u == (gen + 1u) * nloc) {
            __builtin_amdgcn_fence(__ATOMIC_RELEASE, "agent");
            asm volatile("s_waitcnt vmcnt(0)" ::: "memory");
            const unsigned og = xb_add(&bar[XB_TOP], 1u);
            const unsigned tg = og / nx;
            if (og + 1u == (tg + 1u) * nx) xb_add(&bar[XB_TOPGEN], 1u);
            else XB_SPIN(xb_ld(&bar[XB_TOPGEN]) == tg, bar);
            __builtin_amdgcn_fence(__ATOMIC_ACQUIRE, "agent");
            xb_add(&bar[XB_XGEN(b.x)], 1u);
            asm volatile("s_waitcnt vmcnt(0)" ::: "memory");
        } else {
            XB_SPIN(xb_ld(&bar[XB_XGEN(b.x)]) == gen, bar);
            __builtin_amdgcn_fence(__ATOMIC_ACQUIRE, "agent");
            asm volatile("s_waitcnt vmcnt(0)" ::: "memory");
        }
    }
    __syncthreads();
}

constexpr int NWAVES = 8;
constexpr int SCR_BYTES = 147456;
constexpr int MISC_OFF = SCR_BYTES;
constexpr int LDS_BYTES = SCR_BYTES + 1024;
static_assert(NWAVES * WAVE_LDS <= SCR_BYTES, "GLA images");
constexpr size_t WS_BAR = 4096 * 4;
constexpr size_t CTL_ZERO_BYTES = 65536;
#ifndef MK_PER_PHASE
#define MK_PER_PHASE 0
#endif
constexpr int N_PHASES = 11;
struct Args { const float* in[17]; float* out; unsigned char* ws; int ph_lo, ph_hi; };

__global__ void __launch_bounds__(NWAVES * 64, 2) mk_fwd(Args a) {
    extern __shared__ __attribute__((aligned(16))) unsigned char lds_raw[];
    LAS unsigned char* lds = (LAS unsigned char*)lds_raw;
    volatile LAS unsigned* MISC = (volatile LAS unsigned*)(lds + MISC_OFF);
    unsigned char* ws = a.ws; const int G = gridDim.x, bx = blockIdx.x;
    const int tid = threadIdx.x, lane = tid & 63, wave = __builtin_amdgcn_readfirstlane(tid >> 6);
    const int gw = bx * NWAVES + wave, NGW = G * NWAVES;
    const int lo = a.ph_lo, hi = a.ph_hi;
    for (int u = tid; u < (LDS_BYTES - MISC_OFF) / 4; u += NWAVES * 64) MISC[u] = 0u;
    __syncthreads();
    XcdBarrier bar; bar.bar = (unsigned*)(ws + WS_BAR); bar.x = 0; bar.st = nullptr;
    if (!MK_PER_PHASE) bar = xcd_barrier_post((unsigned*)(ws + WS_BAR), MISC + 8);
#define IN(k) (lo <= (k) && (k) < hi)
#define SEAM(k) do { if (IN(k) && IN((k) + 1)) xcd_barrier(bar); } while (0)
    bf16* WIN = (bf16*)(ws + WS_WIN); bf16* WOUT = (bf16*)(ws + WS_WOUT); bf16* WUP = (bf16*)(ws + WS_WUP); bf16* WDN = (bf16*)(ws + WS_WDN); bf16* WPG = (bf16*)(ws + WS_WPG); bf16* WPP = (bf16*)(ws + WS_WPP);
    float* ssq0 = (float*)(ws + WS_SSQ0); float* ssq1 = (float*)(ws + WS_SSQ1); float* ssq2 = (float*)(ws + WS_SSQ2); float* ssq3 = (float*)(ws + WS_SSQ3); float* decay = (float*)(ws + WS_DECAY);
    bf16* xb = (bf16*)(ws + WS_XB); bf16* Sp = xb; bf16* h1b = xb; bf16* zb = (bf16*)(ws + WS_Z); bf16* act = zb; float* la = (float*)(ws + WS_LA); float* U = (float*)(ws + WS_U); bf16* pp = (bf16*)(ws + WS_U);
    bf16* mix = (bf16*)(ws + WS_MIX); bf16* h2b = mix; bf16* pb = (bf16*)(ws + WS_PB);
    float* ghead = (float*)(ws + WS_GHEAD); float* uhead = (float*)(ws + WS_UHEAD); float* gtail = (float*)(ws + WS_GTAIL);
    if (IN(0)) {
        const ProArgs P{a.in[0], a.in[1], a.in[2], a.in[3], a.in[4], a.in[8], a.in[9], a.in[10], a.in[12], a.in[13], a.in[14], a.in[15], WIN, WOUT, WUP, WDN, WPG, WPP, xb, pb, ssq0};
        phase_prologue(P, lds, gw, NGW, wave, lane);
    }
    SEAM(0);
    if (IN(1)) {
        pg8::Gemm g{xb, WIN, T, NIN, DM}; pg8::StaticOrder S; S.init(T, NIN, G, bx);
        pg8::EpiIn E{ssq0, a.in[5], zb, la};
        pg8::gemm_phase<pg8::EpiIn, pg8::StaticOrder, true, true>(lds, g, S, E);
    }
    SEAM(1);
    if (IN(2)) { for (int task = gw; task < 2048; task += NGW) gla_a1(lds + wave * WAVE_LDS, task, zb, la, U, decay, lane); }
    SEAM(2);
    if (IN(3)) { gla_scan(U, decay, Sp, bx * (NWAVES * 64) + tid, G * NWAVES * 64); conv_mix(zb, a.in[7], mix, gw, NGW, lane); }
    SEAM(3);
    if (IN(4)) { for (int task = gw; task < 2048; task += NGW) gla_a3(lds + wave * WAVE_LDS, task, zb, la, Sp, a.in[6], mix, lane); }
    SEAM(4);
    if (IN(5)) {
        __syncthreads();
        pg8::Gemm g{mix, WOUT, T, DM, DM}; pg8::StaticOrder S; S.init(T, DM, G, bx);
        pg8::EpiRes<0> E{a.in[0], a.out, h1b, ssq1, nullptr, nullptr};
        pg8::gemm_phase<pg8::EpiRes<0>, pg8::StaticOrder, true, true>(lds, g, S, E);
    }
    SEAM(5);
    if (IN(6)) {
        pg8::Gemm g{h1b, WUP, T, NUP, DM}; pg8::StaticOrder S; S.init(T, NUP, G, bx);
        pg8::EpiUp E{ssq1, a.in[11], act, ghead, uhead, gtail};
        pg8::gemm_phase<pg8::EpiUp, pg8::StaticOrder, true, true>(lds, g, S, E);
    }
    SEAM(6);
    if (IN(7)) fixup_phase(ghead, uhead, gtail, a.in[11], act, bx * (NWAVES * 64) + tid, G * NWAVES * 64);
    SEAM(7);
    if (IN(8)) {
        { pg8::Gemm g{act, WDN, T, DM, DFF}; pg8::StaticOrder S; S.init(T, DM, G, bx);
          pg8::EpiRes<0> E{a.out, a.out, h2b, ssq2, nullptr, nullptr};
          pg8::gemm_phase<pg8::EpiRes<0>, pg8::StaticOrder, true, true>(lds, g, S, E); }
        { pg8::Gemm g{pb, WPP, T, DM, PLE}; pg8::StaticOrder S; S.init(T, DM, G, bx);
          pg8::EpiBf E{pp, DM};
          pg8::gemm_phase<pg8::EpiBf, pg8::StaticOrder, true, true>(lds, g, S, E); }
    }
    SEAM(8);
    if (IN(9)) {
        pg8::Gemm g{h2b, WPG, T, DM, DM}; pg8::StaticOrder S; S.init(T, DM, G, bx);
        pg8::EpiRes<1> E{a.out, a.out, nullptr, ssq3, ssq2, pp};
        pg8::gemm_phase<pg8::EpiRes<1>, pg8::StaticOrder, true, true>(lds, g, S, E);
    }
    SEAM(9);
    if (IN(10)) final_phase(a.out, ssq3, a.in[16], gw, NGW, lane);
#undef IN
#undef SEAM
}

extern "C" void kernel_launch(void* const* d_in, const int* in_sizes, int n_in, void* d_out, int out_size, void* d_ws, size_t ws_size, hipStream_t stream) {
    static int grid = 0;
    if (grid == 0) {
        if (n_in != 17 || in_sizes[0] != T * DM || out_size != T * DM || ws_size < WS_END) { fprintf(stderr, "kernel_launch: unexpected shapes (n_in %d in0 %d out %d ws %zu)\n", n_in, n_in > 0 ? in_sizes[0] : -1, out_size, ws_size); grid = -1; return; }
        int dev = 0, cus = 0, per_cu = 0;
        if (hipGetDevice(&dev) != hipSuccess || hipDeviceGetAttribute(&cus, hipDeviceAttributeMultiprocessorCount, dev) != hipSuccess) { grid = -1; return; }
        if (hipFuncSetAttribute((const void*)mk_fwd, hipFuncAttributeMaxDynamicSharedMemorySize, LDS_BYTES) != hipSuccess) { fprintf(stderr, "kernel_launch: hipFuncSetAttribute failed\n"); grid = -1; return; }
        if (hipOccupancyMaxActiveBlocksPerMultiprocessor(&per_cu, (const void*)mk_fwd, NWAVES * 64, LDS_BYTES) != hipSuccess || per_cu < 1) { fprintf(stderr, "kernel_launch: occupancy query says %d blocks per CU\n", per_cu); (void)hipGetLastError(); grid = -1; return; }
        grid = cus;
    }
    if (grid < 0) return;
    Args a{}; for (int i = 0; i < 17; ++i) a.in[i] = (const float*)d_in[i]; a.out = (float*)d_out; a.ws = (unsigned char*)d_ws;
#if MK_PER_PHASE
    for (int ph = 0; ph < N_PHASES; ++ph) { a.ph_lo = ph; a.ph_hi = ph + 1; hipLaunchKernelGGL(mk_fwd, dim3(grid), dim3(NWAVES * 64), LDS_BYTES, stream, a); }
#else
    if (hipMemsetAsync((char*)d_ws + WS_CTL, 0, CTL_ZERO_BYTES, stream) != hipSuccess) { fprintf(stderr, "kernel_launch: memset failed\n"); return; }
    a.ph_lo = 0; a.ph_hi = N_PHASES;
    void* kargs[] = {&a};
    const hipError_t e = hipLaunchCooperativeKernel((const void*)mk_fwd, dim3(grid), dim3(NWAVES * 64), kargs, LDS_BYTES, stream);
    if (e != hipSuccess) fprintf(stderr, "kernel_launch: cooperative launch failed: %s (grid %d)\n", hipGetErrorString(e), grid);
#endif
}
```

```cpp
#include <hip/hip_runtime.h>
#include <cstdio>
#include <cstdint>

typedef unsigned short bf16;
constexpr int BATCH = 4, SEQ = 8192, T = BATCH * SEQ, DM = 1024, PLE = 256, DIN = 3088, DFF = 2816;
constexpr int NZ = 3072, NIN = 3328, NUP = 2 * DFF;
constexpr int ZQ = 0, ZK = 256, ZV = 512, ZG = 1024, ZCB = 1536, ZCC = 2048, ZCX = 2560;
constexpr float EPS = 1e-6f;
constexpr size_t MiB = 1u << 20;
constexpr size_t WS_CTL = 0;
constexpr size_t WS_WIN = 1 * MiB, WS_WOUT = 8 * MiB, WS_WUP = 10 * MiB, WS_WDN = 21 * MiB, WS_WPG = 27 * MiB, WS_WPP = 29 * MiB;
constexpr size_t WS_SSQ0 = 30 * MiB, WS_SSQ1 = 31 * MiB, WS_SSQ2 = 32 * MiB, WS_SSQ3 = 33 * MiB, WS_DECAY = 34 * MiB;
constexpr size_t WS_GHEAD = 36 * MiB, WS_UHEAD = 39 * MiB, WS_GTAIL = 42 * MiB;
constexpr size_t WS_XB = 48 * MiB;
constexpr size_t WS_Z = 112 * MiB;
constexpr size_t WS_LA = 304 * MiB;
constexpr size_t WS_U = 336 * MiB;
constexpr size_t WS_MIX = 400 * MiB;
constexpr size_t WS_PB = 464 * MiB;
constexpr size_t WS_END = 480 * MiB;

__device__ __forceinline__ unsigned f2bf(float f) { unsigned u = __builtin_bit_cast(unsigned, f); return (u + 0x7fffu + ((u >> 16) & 1u)) >> 16; }
__device__ __forceinline__ float bf2f(bf16 h) { return __builtin_bit_cast(float, (unsigned)h << 16); }
__device__ __forceinline__ float sigmoidf_(float x) { return __builtin_amdgcn_rcpf(1.0f + __builtin_amdgcn_exp2f(-1.44269504089f * x)); }
__device__ __forceinline__ float siluf_(float x) { return x * sigmoidf_(x); }
namespace pg8 {
#define PG8_LAS __attribute__((address_space(3)))
typedef unsigned short bf16_t;
typedef short bf16x8 __attribute__((ext_vector_type(8)));
typedef float f32x4 __attribute__((ext_vector_type(4)));
typedef unsigned u32x4 __attribute__((ext_vector_type(4)));
constexpr int BM = 256, BK = 64, HALF = 128, HTB = HALF * BK * 2  , STAGE_BYTES = 8 * HTB, NXCD = 8, WGM = 8;

__host__ __device__ __forceinline__ int lds_byte(int r, int c) { const int st = (r >> 4) * 2 + (c >> 5), rr = r & 15, cc = c & 31, ob = rr * 64 + cc * 2; return st * 1024 + (ob ^ (((ob >> 9) & 1) << 5)); }
__host__ __device__ __forceinline__ void stage_rc(int b, int& R, int& C) { const int st = b / 1024, sb = b % 1024, swz = sb ^ (((sb >> 9) & 1) << 5); R = (st >> 1) * 16 + swz / 64; C = (st & 1) * 32 + (swz % 64) / 2; }
__host__ __device__ __forceinline__ int perm32(int rho) { const int n = rho >> 4, i = rho & 15; return 8 * (i >> 2) + 4 * n + (i & 3); }

struct Unit { int pm, pn; };
struct Gemm { const bf16_t* A; const bf16_t* Bt; int M, N, K; };

struct StaticOrder {
    int nM, nN, nwg, G, c;
    __host__ __device__ void init(int M, int N, int G_, int c_) { nM = M / BM; nN = N / BM; nwg = nM * nN; G = G_; c = c_; }
    __host__ __device__ bool next(int i, Unit& u) const {
        const long L = (long)i * G + c; if (L >= nwg) return false;
        int wgid = (int)L; { const int q = nwg / NXCD, r = nwg % NXCD, xcd = wgid % NXCD, off = wgid / NXCD; wgid = (xcd < r ? xcd * (q + 1) : r * (q + 1) + (xcd - r) * q) + off; }
        const int nig = WGM * nN, gid = wgid / nig, fm = gid * WGM, gsz = (nM - fm) < WGM ? (nM - fm) : WGM;
        u.pm = fm + ((wgid % nig) % gsz); u.pn = (wgid % nig) / gsz; return true;
    }
    __device__ __forceinline__ void a_ready(const Unit&) const {}
    __device__ __forceinline__ void done(const Unit&) const {}
};


__device__ __forceinline__ unsigned cvt_pk_bf16(float lo, float hi) { unsigned r; asm volatile("v_cvt_pk_bf16_f32 %0, %1, %2" : "=v"(r) : "v"(lo), "v"(hi)); return r; }
__device__ __forceinline__ u32x4 pack8(const f32x4 a, const f32x4 b) { u32x4 w; w.x = cvt_pk_bf16(a[0], a[1]); w.y = cvt_pk_bf16(a[2], a[3]); w.z = cvt_pk_bf16(b[0], b[1]); w.w = cvt_pk_bf16(b[2], b[3]); return w; }
__device__ __forceinline__ float fast_sigmoid(float x) { return __builtin_amdgcn_rcpf(1.0f + __builtin_amdgcn_exp2f(-1.44269504089f * x)); }
__device__ __forceinline__ float rstd_sum4(const float* p4) { const f32x4 s = *(const f32x4*)p4; return __builtin_amdgcn_rsqf(((s[0] + s[1]) + (s[2] + s[3])) * (1.0f / 1024.0f) + 1e-6f); }
__device__ __forceinline__ float logsig16(float x) { const float e = __builtin_amdgcn_exp2f(-1.44269504089f * __builtin_fabsf(x)); return (__builtin_fminf(x, 0.f) - 0.69314718056f * __builtin_amdgcn_logf(1.0f + e)) * 0.0625f; }

struct EpiIn {
    static constexpr bool PERM = true, AFTER_DRAIN = false;
    const float* ssq0; const float* b_alpha; bf16_t* z; float* la;
    __device__ __forceinline__ void operator()(f32x4 (&acc)[2][2][4][2], const Unit& u, int wr, int wc, int fr, int fq, PG8_LAS unsigned char*, int) const {
        const int row0 = u.pm * BM + wr * 64 + fr, colw = wc * 32 + 8 * fq;
        if (u.pn < 12) {
#pragma unroll
            for (int ai = 0; ai < 2; ++ai)
#pragma unroll
                for (int m = 0; m < 4; ++m) { const int row = row0 + ai * HALF + m * 16; const float rs = __builtin_amdgcn_rsqf(ssq0[row] * (1.0f / 1024.0f) + 1e-6f);
                    bf16_t* rowp = z + (size_t)row * 3072 + u.pn * BM + colw;
#pragma unroll
                    for (int bj = 0; bj < 2; ++bj) *(u32x4*)(rowp + bj * HALF) = pack8(acc[ai][bj][m][0] * rs, acc[ai][bj][m][1] * rs); }
        } else {
            f32x4 bv[2][2];
#pragma unroll
            for (int bj = 0; bj < 2; ++bj)
#pragma unroll
                for (int n = 0; n < 2; ++n) bv[bj][n] = *(const f32x4*)(b_alpha + bj * HALF + colw + 4 * n);
#pragma unroll
            for (int ai = 0; ai < 2; ++ai)
#pragma unroll
                for (int m = 0; m < 4; ++m) { const int row = row0 + ai * HALF + m * 16; const float rs = __builtin_amdgcn_rsqf(ssq0[row] * (1.0f / 1024.0f) + 1e-6f);
                    float* rowp = la + (size_t)row * 256 + colw;
#pragma unroll
                    for (int bj = 0; bj < 2; ++bj)
#pragma unroll
                        for (int n = 0; n < 2; ++n) { const f32x4 v = acc[ai][bj][m][n] * rs + bv[bj][n]; f32x4 o; o[0] = logsig16(v[0]); o[1] = logsig16(v[1]); o[2] = logsig16(v[2]); o[3] = logsig16(v[3]);
                            *(f32x4*)(rowp + bj * HALF + 4 * n) = o; } }
        }
    }
};
struct EpiBf {
    static constexpr bool PERM = true, AFTER_DRAIN = false;
    bf16_t* O; int ldc;
    __device__ __forceinline__ void operator()(f32x4 (&acc)[2][2][4][2], const Unit& u, int wr, int wc, int fr, int fq, PG8_LAS unsigned char*, int) const {
        const int row0 = u.pm * BM + wr * 64 + fr, col0 = u.pn * BM + wc * 32 + 8 * fq;
#pragma unroll
        for (int ai = 0; ai < 2; ++ai)
#pragma unroll
            for (int m = 0; m < 4; ++m) { bf16_t* rowp = O + (size_t)(row0 + ai * HALF + m * 16) * ldc + col0;
#pragma unroll
                for (int bj = 0; bj < 2; ++bj) *(u32x4*)(rowp + bj * HALF) = pack8(acc[ai][bj][m][0], acc[ai][bj][m][1]); }
    }
};
__device__ __forceinline__ void unpack8(const u32x4 w, f32x4& a, f32x4& b) {
    a[0] = __builtin_bit_cast(float, w.x << 16); a[1] = __builtin_bit_cast(float, w.x & 0xffff0000u); a[2] = __builtin_bit_cast(float, w.y << 16); a[3] = __builtin_bit_cast(float, w.y & 0xffff0000u);
    b[0] = __builtin_bit_cast(float, w.z << 16); b[1] = __builtin_bit_cast(float, w.z & 0xffff0000u); b[2] = __builtin_bit_cast(float, w.w << 16); b[3] = __builtin_bit_cast(float, w.w & 0xffff0000u); }
template <int MODE, bool BASEB, bool OUTF> struct EpiRes {
    static constexpr bool PERM = true, AFTER_DRAIN = false;
    const float* basef; const bf16_t* baseb; float* out; bf16_t* hb; float* ssq_out; const float* ssq_in; const bf16_t* pp;
    __device__ __forceinline__ void operator()(f32x4 (&acc)[2][2][4][2], const Unit& u, int wr, int wc, int fr, int fq, PG8_LAS unsigned char* les, int tid) const {
        const int rowt = wr * 64 + fr, col0 = u.pn * BM + wc * 32 + 8 * fq;
        PG8_LAS float* red = (PG8_LAS float*)les;
#pragma unroll
        for (int ai = 0; ai < 2; ++ai)
#pragma unroll
            for (int m = 0; m < 4; ++m) { const int rt = rowt + ai * HALF + m * 16; const size_t off = (size_t)(u.pm * BM + rt) * 1024 + col0;
                float rs = 1.f; if (MODE == 1) rs = rstd_sum4(ssq_in + (size_t)(u.pm * BM + rt) * 4);
                float sq = 0.f;
#pragma unroll
                for (int bj = 0; bj < 2; ++bj) { f32x4 v0, v1;
                    if (BASEB) unpack8(*(const u32x4*)(baseb + off + bj * HALF), v0, v1);
                    else { v0 = *(const f32x4*)(basef + off + bj * HALF); v1 = *(const f32x4*)(basef + off + bj * HALF + 4); }
                    if (MODE == 0) { v0 += acc[ai][bj][m][0]; v1 += acc[ai][bj][m][1]; }
                    else { f32x4 p0, p1; unpack8(*(const u32x4*)(pp + off + bj * HALF), p0, p1); const f32x4 a0 = acc[ai][bj][m][0] * rs, a1 = acc[ai][bj][m][1] * rs;
#pragma unroll
                        for (int e = 0; e < 4; ++e) { v0[e] += fast_sigmoid(a0[e]) * p0[e]; v1[e] += fast_sigmoid(a1[e]) * p1[e]; } }
                    if (OUTF) { *(f32x4*)(out + off + bj * HALF) = v0; *(f32x4*)(out + off + bj * HALF + 4) = v1; }
                    else *(u32x4*)(hb + off + bj * HALF) = pack8(v0, v1);
                    sq += (v0[0] * v0[0] + v0[1] * v0[1]) + (v0[2] * v0[2] + v0[3] * v0[3]) + (v1[0] * v1[0] + v1[1] * v1[1]) + (v1[2] * v1[2] + v1[3] * v1[3]); }
                sq += __shfl_xor(sq, 16); sq += __shfl_xor(sq, 32);
                if (fq == 0) red[rt * 4 + wc] = sq; }
        asm volatile("s_waitcnt lgkmcnt(0)" ::: "memory"); __builtin_amdgcn_s_barrier(); asm volatile("" ::: "memory");
        if (tid < 256) { const f32x4 r = *(const PG8_LAS f32x4*)(red + tid * 4); ssq_out[(size_t)(u.pm * BM + tid) * 4 + u.pn] = (r[0] + r[1]) + (r[2] + r[3]); }
    }
};
__device__ __forceinline__ float dpp_shr1(float old, float src) { return __builtin_bit_cast(float, __builtin_amdgcn_update_dpp(__builtin_bit_cast(int, old), __builtin_bit_cast(int, src), 0x111, 0xf, 0xf, false)); }
__device__ __forceinline__ float dpp_shr2(float old, float src) { return __builtin_bit_cast(float, __builtin_amdgcn_update_dpp(__builtin_bit_cast(int, old), __builtin_bit_cast(int, src), 0x112, 0xf, 0xf, false)); }
__device__ __forceinline__ float dpp_ror1(float src) { return __builtin_bit_cast(float, __builtin_amdgcn_update_dpp(0, __builtin_bit_cast(int, src), 0x121, 0xf, 0xf, false)); }
__device__ __forceinline__ float dpp_ror2(float src) { return __builtin_bit_cast(float, __builtin_amdgcn_update_dpp(0, __builtin_bit_cast(int, src), 0x122, 0xf, 0xf, false)); }
struct EpiUp {
    static constexpr bool PERM = true, AFTER_DRAIN = false;
    const float* ssq1p; const float* cw; bf16_t* act; float* ghead; float* uhead; float* gtail;
    __device__ __forceinline__ void operator()(f32x4 (&acc)[2][2][4][2], const Unit& u, int wr, int wc, int fr, int fq, PG8_LAS unsigned char* les, int) const {
        constexpr int FF = 2816;
        const int rowt = wr * 64 + fr, cw0 = wc * 32 + 8 * fq, gc0 = u.pn * HALF + cw0;
        PG8_LAS float* H = (PG8_LAS float*)les;
#pragma unroll
        for (int ai = 0; ai < 2; ++ai)
#pragma unroll
            for (int m = 0; m < 4; ++m) { const float rs = rstd_sum4(ssq1p + (size_t)(u.pm * BM + rowt + ai * HALF + m * 16) * 4);
#pragma unroll
                for (int bj = 0; bj < 2; ++bj)
#pragma unroll
                    for (int n = 0; n < 2; ++n) acc[ai][bj][m][n] *= rs; }
        if (fr >= 14) {
#pragma unroll
            for (int ai = 0; ai < 2; ++ai)
#pragma unroll
                for (int n = 0; n < 2; ++n) *(PG8_LAS f32x4*)(H + ((ai * 2 + wr) * 2 + (fr - 14)) * HALF + cw0 + 4 * n) = acc[ai][0][3][n];
            if (wr == 1) {
#pragma unroll
                for (int n = 0; n < 2; ++n) *(f32x4*)(gtail + (size_t)(u.pm * 2 + (fr - 14)) * FF + gc0 + 4 * n) = acc[1][0][3][n]; }
        }
        if (wr == 0 && fr < 2) {
#pragma unroll
            for (int n = 0; n < 2; ++n) { *(f32x4*)(ghead + (size_t)(u.pm * 2 + fr) * FF + gc0 + 4 * n) = acc[0][0][0][n]; *(f32x4*)(uhead + (size_t)(u.pm * 2 + fr) * FF + gc0 + 4 * n) = acc[0][1][0][n]; }
        }
        asm volatile("s_waitcnt lgkmcnt(0)" ::: "memory"); __builtin_amdgcn_s_barrier(); asm volatile("" ::: "memory");
        f32x4 w0[2], w1[2], w2[2];
#pragma unroll
        for (int n = 0; n < 2; ++n) { w0[n] = *(const f32x4*)(cw + gc0 + 4 * n); w1[n] = *(const f32x4*)(cw + FF + gc0 + 4 * n); w2[n] = *(const f32x4*)(cw + 2 * FF + gc0 + 4 * n); }
#pragma unroll
        for (int ai = 0; ai < 2; ++ai) {
            f32x4 hm1[2], hm2[2];
            if (ai == 0 && wr == 0) { hm1[0] = hm1[1] = hm2[0] = hm2[1] = (f32x4){0.f, 0.f, 0.f, 0.f}; }
            else { const int s = (wr == 1) ? (ai * 2) : ((ai - 1) * 2 + 1);
#pragma unroll
                for (int n = 0; n < 2; ++n) { hm2[n] = *(const PG8_LAS f32x4*)(H + (s * 2 + 0) * HALF + cw0 + 4 * n); hm1[n] = *(const PG8_LAS f32x4*)(H + (s * 2 + 1) * HALF + cw0 + 4 * n); } }
#pragma unroll
            for (int m = 0; m < 4; ++m) {
                f32x4 a[2];
#pragma unroll
                for (int n = 0; n < 2; ++n)
#pragma unroll
                    for (int e = 0; e < 4; ++e) {
                        const float g = acc[ai][0][m][n][e];
                        float o1, o2;
                        if (m == 0) { o1 = hm1[n][e]; o2 = (fr == 0) ? hm2[n][e] : hm1[n][e]; }
                        else { const float gp = acc[ai][0][m - 1][n][e]; o1 = dpp_ror1(gp); o2 = dpp_ror2(gp); }
                        const float gm1 = dpp_shr1(o1, g), gm2 = dpp_shr2(o2, g);
                        const float cv = w2[n][e] * g + w1[n][e] * gm1 + w0[n][e] * gm2;
                        a[n][e] = cv * fast_sigmoid(cv) * acc[ai][1][m][n][e];
                    }
                *(u32x4*)(act + (size_t)(u.pm * BM + rowt + ai * HALF + m * 16) * FF + gc0) = pack8(a[0], a[1]);
            }
        }
    }
};
template <class Epi, class Sched, bool ALIGN_EPI = false, bool SP2 = false>
__device__ __forceinline__ void gemm_phase(PG8_LAS unsigned char* lds, const Gemm g, const Sched& S, const Epi& E) {
    const int tid = threadIdx.x, wid = __builtin_amdgcn_readfirstlane(tid >> 6), lane = tid & 63, wr = wid >> 2, wc = wid & 3, fr = lane & 15, fq = lane >> 4;
    const int K = g.K, nt = K / BK;
    unsigned voffA[2], voffB[2];
#pragma unroll
    for (int i = 0; i < 2; ++i) { int R, C; stage_rc(tid * 16 + i * 8192, R, C); const int Rb = Epi::PERM ? ((R & ~31) + perm32(R & 31)) : R;
        voffA[i] = (unsigned)(R * K + C) * 2u; voffB[i] = (unsigned)(Rb * K + C) * 2u; }
    const size_t kstep = (size_t)(BK * 2);
    const size_t hstep = (size_t)HALF * K * 2;
    const size_t tstep = 2 * hstep;
    const unsigned ldsw = (unsigned)wid * 1024u;
    const int aoff = lds_byte(wr * 64 + fr, fq * 8), boff = lds_byte(wc * 32 + fr, fq * 8);
#define PG8_SA(b, h) (((b) * 2 + (h)) * HTB)
#define PG8_SB(b, h) ((4 + (b) * 2 + (h)) * HTB)
#define PG8_STAGE(bufoff, gbase, voff) do { _Pragma("unroll") for (int _i = 0; _i < 2; ++_i) \
        __builtin_amdgcn_global_load_lds((const unsigned*)((const char*)(gbase) + (voff)[_i]), (PG8_LAS unsigned*)(lds + (bufoff) + ldsw + _i * 8192), 16, 0, 0); } while (0)
#define PG8_LDA(dst, b, h) do { _Pragma("unroll") for (int m = 0; m < 4; ++m) _Pragma("unroll") for (int k = 0; k < 2; ++k) dst[m][k] = *(const PG8_LAS bf16x8*)(lds + PG8_SA(b, h) + aoff + m * 2048 + k * 1024); } while (0)
#define PG8_LDB(dst, b, h) do { _Pragma("unroll") for (int n = 0; n < 2; ++n) _Pragma("unroll") for (int k = 0; k < 2; ++k) dst[n][k] = *(const PG8_LAS bf16x8*)(lds + PG8_SB(b, h) + boff + n * 2048 + k * 1024); } while (0)
#define PG8_MMA(ai, bj, At, Bt) do { __builtin_amdgcn_s_setprio(1); _Pragma("unroll") for (int m = 0; m < 4; ++m) _Pragma("unroll") for (int n = 0; n < 2; ++n) _Pragma("unroll") for (int k = 0; k < 2; ++k) \
        acc[ai][bj][m][n] = __builtin_amdgcn_mfma_f32_16x16x32_bf16(Bt[n][k], At[m][k], acc[ai][bj][m][n], 0, 0, 0); __builtin_amdgcn_s_setprio(0); } while (0)
#define PG8_WAIT_V(n) asm volatile("s_waitcnt vmcnt(" #n ")" ::: "memory")
#define PG8_WAIT_L(n) asm volatile("s_waitcnt lgkmcnt(" #n ")" ::: "memory")
#define PG8_BAR __builtin_amdgcn_s_barrier()
#define PG8_SCHED __builtin_amdgcn_sched_barrier(0)
    Unit cur, nxt; int ui = 0;
    if (!S.next(0, cur)) return;
    f32x4 acc[2][2][4][2];
#pragma unroll
    for (int a = 0; a < 2; ++a)
#pragma unroll
        for (int b = 0; b < 2; ++b)
#pragma unroll
            for (int m = 0; m < 4; ++m)
#pragma unroll
                for (int n = 0; n < 2; ++n) acc[a][b][m][n] = (f32x4){0.f, 0.f, 0.f, 0.f};
    bf16x8 At[4][2], B0[2][2], B1[2][2];
    const char* cA = (const char*)g.A + (size_t)cur.pm * tstep; const char* cB = (const char*)g.Bt + (size_t)cur.pn * tstep;
    S.a_ready(cur);
    if constexpr (SP2) {
        PG8_STAGE(PG8_SB(0, 0), cB, voffB); PG8_STAGE(PG8_SB(0, 1), cB + hstep, voffB); PG8_STAGE(PG8_SA(0, 0), cA, voffA); PG8_STAGE(PG8_SA(0, 1), cA + hstep, voffA);
        if (wr == 1) PG8_BAR;
        PG8_WAIT_V(2); PG8_BAR;
        PG8_STAGE(PG8_SB(1, 0), cB + kstep, voffB); PG8_STAGE(PG8_SA(1, 0), cA + kstep, voffA); PG8_STAGE(PG8_SB(1, 1), cB + hstep + kstep, voffB);
        PG8_WAIT_V(6); PG8_BAR;
    } else {
        PG8_STAGE(PG8_SB(0, 0), cB, voffB); PG8_STAGE(PG8_SA(0, 0), cA, voffA); PG8_STAGE(PG8_SB(0, 1), cB + hstep, voffB); PG8_STAGE(PG8_SA(0, 1), cA + hstep, voffA);
        if (wr == 1) PG8_BAR;
        PG8_WAIT_V(4); PG8_BAR;
        PG8_STAGE(PG8_SB(1, 0), cB + kstep, voffB); PG8_STAGE(PG8_SA(1, 0), cA + kstep, voffA); PG8_STAGE(PG8_SB(1, 1), cB + hstep + kstep, voffB);
        PG8_WAIT_V(6); PG8_BAR;
    }
    for (;;) {
        const bool has_next = S.next(ui + 1, nxt);
        const char* nA = has_next ? (const char*)g.A + (size_t)nxt.pm * tstep : cA; const char* nB = has_next ? (const char*)g.Bt + (size_t)nxt.pn * tstep : cB;
        for (int t = 0; t < nt; t += 2) {
            const bool last = (t == nt - 2);
            const char* a1 = cA + (size_t)(t + 1) * kstep;
            const char* a2 = last ? nA : cA + (size_t)(t + 2) * kstep; const char* b2 = last ? nB : cB + (size_t)(t + 2) * kstep;
            const char* a3 = a2 + kstep; const char* b3 = b2 + kstep;
            if (last && has_next) S.a_ready(nxt);
            if constexpr (SP2) {
            PG8_LDB(B0, 0, 0); PG8_LDB(B1, 0, 1); PG8_SCHED; PG8_LDA(At, 0, 0); PG8_STAGE(PG8_SA(1, 1), a1 + hstep, voffA);
            PG8_WAIT_V(8); PG8_WAIT_L(0); PG8_BAR; PG8_MMA(0, 0, At, B0); PG8_MMA(0, 1, At, B1); PG8_BAR; PG8_SCHED;
            PG8_LDA(At, 0, 1); PG8_STAGE(PG8_SB(0, 0), b2, voffB); PG8_STAGE(PG8_SB(0, 1), b2 + hstep, voffB); PG8_STAGE(PG8_SA(0, 0), a2, voffA);
            PG8_WAIT_V(8); PG8_WAIT_L(0); PG8_BAR; PG8_MMA(1, 0, At, B0); PG8_MMA(1, 1, At, B1); PG8_BAR; PG8_SCHED;
            PG8_LDB(B0, 1, 0); PG8_LDB(B1, 1, 1); PG8_SCHED; PG8_LDA(At, 1, 0); PG8_STAGE(PG8_SA(0, 1), a2 + hstep, voffA);
            PG8_WAIT_V(8); PG8_WAIT_L(0); PG8_BAR; PG8_MMA(0, 0, At, B0); PG8_MMA(0, 1, At, B1); PG8_BAR; PG8_SCHED;
            PG8_LDA(At, 1, 1); PG8_STAGE(PG8_SB(1, 0), b3, voffB); PG8_STAGE(PG8_SB(1, 1), b3 + hstep, voffB); PG8_STAGE(PG8_SA(1, 0), a3, voffA);
            PG8_WAIT_V(8); PG8_WAIT_L(0); PG8_BAR; PG8_MMA(1, 0, At, B0); PG8_MMA(1, 1, At, B1); PG8_BAR; PG8_SCHED;
            } else {
            PG8_LDB(B0, 0, 0); PG8_SCHED; PG8_LDA(At, 0, 0); PG8_STAGE(PG8_SA(1, 1), a1 + hstep, voffA);
            PG8_WAIT_L(8); PG8_BAR; PG8_WAIT_L(0); PG8_MMA(0, 0, At, B0); PG8_BAR; PG8_SCHED;
            PG8_LDB(B1, 0, 1); PG8_STAGE(PG8_SB(0, 0), b2, voffB);
            PG8_BAR; PG8_WAIT_L(0); PG8_MMA(0, 1, At, B1); PG8_BAR;
            PG8_LDA(At, 0, 1); PG8_STAGE(PG8_SA(0, 0), a2, voffA);
            PG8_BAR; PG8_WAIT_L(0); PG8_MMA(1, 0, At, B0); PG8_BAR; PG8_SCHED;
            PG8_STAGE(PG8_SB(0, 1), b2 + hstep, voffB);
            PG8_WAIT_V(6); PG8_BAR; PG8_MMA(1, 1, At, B1); PG8_BAR;
            PG8_LDB(B0, 1, 0); PG8_SCHED; PG8_LDA(At, 1, 0); PG8_STAGE(PG8_SA(0, 1), a2 + hstep, voffA);
            PG8_WAIT_L(8); PG8_BAR; PG8_WAIT_L(0); PG8_MMA(0, 0, At, B0); PG8_BAR; PG8_SCHED;
            PG8_LDB(B1, 1, 1); PG8_STAGE(PG8_SB(1, 0), b3, voffB);
            PG8_BAR; PG8_WAIT_L(0); PG8_MMA(0, 1, At, B1); PG8_BAR;
            PG8_LDA(At, 1, 1); PG8_STAGE(PG8_SA(1, 0), a3, voffA);
            PG8_BAR; PG8_WAIT_L(0); PG8_MMA(1, 0, At, B0); PG8_BAR; PG8_SCHED;
            PG8_STAGE(PG8_SB(1, 1), b3 + hstep, voffB);
            PG8_WAIT_V(6); PG8_BAR; PG8_MMA(1, 1, At, B1); PG8_BAR;
            }
        }
        if constexpr (ALIGN_EPI) { if (wr == 0) PG8_BAR; }
        if constexpr (!Epi::AFTER_DRAIN) { E(acc, cur, wr, wc, fr, fq, lds + STAGE_BYTES, tid); S.done(cur); }
        if (!has_next) break;
#pragma unroll
        for (int a = 0; a < 2; ++a)
#pragma unroll
            for (int b = 0; b < 2; ++b)
#pragma unroll
                for (int m = 0; m < 4; ++m)
#pragma unroll
                    for (int n = 0; n < 2; ++n) acc[a][b][m][n] = (f32x4){0.f, 0.f, 0.f, 0.f};
        cur = nxt; cA = nA; cB = nB; ++ui;
        if constexpr (ALIGN_EPI) { if (wr == 1) PG8_BAR; }
    }
    PG8_WAIT_V(0);
    if constexpr (!ALIGN_EPI) { if (wr == 0) PG8_BAR; }
    PG8_BAR;
    (void)lane;
#undef PG8_SA
#undef PG8_SB
#undef PG8_STAGE
#undef PG8_LDA
#undef PG8_LDB
#undef PG8_MMA
#undef PG8_WAIT_V
#undef PG8_WAIT_L
#undef PG8_BAR
#undef PG8_SCHED
}
}

#define LAS __attribute__((address_space(3)))
typedef unsigned v4u __attribute__((ext_vector_type(4)));
typedef unsigned v2u __attribute__((ext_vector_type(2)));
typedef float f32x4 __attribute__((ext_vector_type(4)));
typedef float f32x2 __attribute__((ext_vector_type(2)));
typedef float f32x16 __attribute__((ext_vector_type(16)));
typedef short bf16x8 __attribute__((ext_vector_type(8)));
#define LDS_FENCE() asm volatile("s_waitcnt lgkmcnt(0)" ::: "memory")
#define MFMA32(a, b, c) __builtin_amdgcn_mfma_f32_32x32x16_bf16((a), (b), (c), 0, 0, 0)
__device__ __forceinline__ unsigned pk2(float lo, float hi) { return f2bf(lo) | (f2bf(hi) << 16); }
__device__ __forceinline__ float bflo(unsigned w) { return __builtin_bit_cast(float, w << 16); }
__device__ __forceinline__ float bfhi(unsigned w) { return __builtin_bit_cast(float, w & 0xffff0000u); }
__device__ __forceinline__ int crow(int r, int h) { return (r & 3) + 8 * (r >> 2) + 4 * h; }

template <class Src> __device__ __forceinline__ void wt_item(const Src& src, int K, bf16* WT, int kb, int nb, const float* gain, LAS float* scr, int lane) {
    const int k0 = 64 * kb, n0 = 32 * nb;
#pragma unroll 8
    for (int i = 0; i < 32; ++i) { const int kk = 2 * i + (lane >> 5); float v = src(k0 + kk, n0 + (lane & 31)); if (gain) v *= gain[k0 + kk]; scr[kk * 33 + (lane & 31)] = v; }
    LDS_FENCE();
    const int c = lane & 7;
#pragma unroll
    for (int j = 0; j < 4; ++j) { const int n = (lane >> 3) + 8 * j; const LAS float* s = scr + (8 * c) * 33 + n;
        v4u o; o.x = pk2(s[0 * 33], s[1 * 33]); o.y = pk2(s[2 * 33], s[3 * 33]); o.z = pk2(s[4 * 33], s[5 * 33]); o.w = pk2(s[6 * 33], s[7 * 33]);
        *(v4u*)(WT + (size_t)(n0 + n) * K + k0 + 8 * c) = o; }
    LDS_FENCE();
}
struct SrcPlain { const float* W; int N; int mode;
    __device__ __forceinline__ float operator()(int k, int n) const { int col = n; if (mode == 1) col = n < 1536 ? n : n + 16; else if (mode == 2) { const int j = n >> 8, i = n & 255; col = i < 128 ? 128 * j + i : DFF + 128 * j + (i - 128); } return W[(size_t)k * N + col]; } };
struct SrcAlpha { const float* w_in; const float* wau;
    __device__ __forceinline__ float operator()(int k, int c) const { float s = 0.f;
#pragma unroll
        for (int r = 0; r < 16; ++r) s += w_in[(size_t)k * DIN + 1536 + r] * wau[r * 256 + c]; return s; } };
__device__ __forceinline__ float wave_sum(float v) {
#pragma unroll
    for (int o = 1; o < 64; o <<= 1) v += __shfl_xor(v, o);
    return v; }
struct ProArgs { const float *x, *p, *attn_norm, *w_in, *wau, *w_out, *ffn_norm, *w_up, *w_down, *ple_norm, *w_pg, *w_pp; bf16 *WIN, *WOUT, *WUP, *WDN, *WPG, *WPP, *xb, *pb; float* ssq0; };
__device__ __forceinline__ void phase_prologue(const ProArgs& A, LAS unsigned char* lds, int gw, int NGW, int wave, int lane) {
    LAS float* scr = (LAS float*)(lds + wave * 16384);
    constexpr int I_IN = 16 * 96, I_AL = 16 * 8, I_O = 16 * 32, I_UP = 16 * 176, I_DN = 44 * 32, I_PG = 16 * 32, I_PP = 4 * 32;
    constexpr int NITEMS = I_IN + I_AL + I_O + I_UP + I_DN + I_PG + I_PP;
    for (int it = gw; it < NITEMS; it += NGW) {
        int r = it;
        if (r < I_IN) { wt_item(SrcPlain{A.w_in, DIN, 1}, DM, A.WIN, r / 96, r % 96, A.attn_norm, scr, lane); continue; } r -= I_IN;
        if (r < I_AL) { wt_item(SrcAlpha{A.w_in, A.wau}, DM, A.WIN + (size_t)NZ * DM, r / 8, r % 8, A.attn_norm, scr, lane); continue; } r -= I_AL;
        if (r < I_O) { wt_item(SrcPlain{A.w_out, DM, 0}, DM, A.WOUT, r / 32, r % 32, nullptr, scr, lane); continue; } r -= I_O;
        if (r < I_UP) { wt_item(SrcPlain{A.w_up, NUP, 2}, DM, A.WUP, r / 176, r % 176, A.ffn_norm, scr, lane); continue; } r -= I_UP;
        if (r < I_DN) { wt_item(SrcPlain{A.w_down, DM, 0}, DFF, A.WDN, r / 32, r % 32, nullptr, scr, lane); continue; } r -= I_DN;
        if (r < I_PG) { wt_item(SrcPlain{A.w_pg, DM, 0}, DM, A.WPG, r / 32, r % 32, A.ple_norm, scr, lane); continue; } r -= I_PG;
        wt_item(SrcPlain{A.w_pp, DM, 0}, PLE, A.WPP, r / 32, r % 32, nullptr, scr, lane);
    }
    for (int m0 = gw * 4; m0 < T; m0 += NGW * 4) {
        f32x4 v[4][4]; f32x4 pv[4];
#pragma unroll
        for (int r = 0; r < 4; ++r) { const f32x4* xr = (const f32x4*)(A.x + (size_t)(m0 + r) * DM) + lane;
#pragma unroll
            for (int j = 0; j < 4; ++j) v[r][j] = xr[64 * j];
            pv[r] = ((const f32x4*)(A.p + (size_t)(m0 + r) * PLE))[lane]; }
#pragma unroll
        for (int r = 0; r < 4; ++r) { unsigned long long* o8 = (unsigned long long*)(A.xb + (size_t)(m0 + r) * DM) + lane; float s = 0.f;
#pragma unroll
            for (int j = 0; j < 4; ++j) { s += (v[r][j][0] * v[r][j][0] + v[r][j][1] * v[r][j][1]) + (v[r][j][2] * v[r][j][2] + v[r][j][3] * v[r][j][3]);
                o8[64 * j] = (unsigned long long)pk2(v[r][j][0], v[r][j][1]) | ((unsigned long long)pk2(v[r][j][2], v[r][j][3]) << 32); }
            s = wave_sum(s); if (lane == 0) A.ssq0[m0 + r] = s;
            ((unsigned long long*)(A.pb + (size_t)(m0 + r) * PLE))[lane] = (unsigned long long)pk2(pv[r][0], pv[r][1]) | ((unsigned long long)pk2(pv[r][2], pv[r][3]) << 32); }
    }
}

constexpr int IMG_STRIDE = 144, IMG_BYTES = 64 * IMG_STRIDE, WAVE_LDS = 2 * IMG_BYTES;
__device__ __forceinline__ bf16x8 img_frag(const LAS unsigned char* img, int row, int s, int hh) { return *(const LAS bf16x8*)(img + row * IMG_STRIDE + (16 * s + 8 * hh) * 2); }
__device__ __forceinline__ f32x16 zero16() { f32x16 z; for (int i = 0; i < 16; ++i) z[i] = 0.f; return z; }

__device__ __forceinline__ void load_vt_half(LAS unsigned char* img, const bf16* __restrict__ vp, int lane) {
#pragma unroll 4
    for (int t8 = 0; t8 < 8; ++t8) { unsigned e[8];
#pragma unroll
        for (int j = 0; j < 8; ++j) e[j] = vp[(size_t)(t8 * 8 + j) * NZ];
        v4u w; w.x = e[0] | (e[1] << 16); w.y = e[2] | (e[3] << 16); w.z = e[4] | (e[5] << 16); w.w = e[6] | (e[7] << 16);
        *(LAS v4u*)(img + lane * IMG_STRIDE + t8 * 16) = w; }
}
__device__ __forceinline__ void gla_a1(LAS unsigned char* wl, int task, const bf16* __restrict__ z, const float* __restrict__ la, float* __restrict__ U, float* __restrict__ decay, int lane) {
    const int bh = task >> 7, n = task & 127, b = bh >> 2, h = bh & 3, hh = lane >> 5, l31 = lane & 31;
    const size_t t0 = (size_t)b * SEQ + (size_t)n * 64;
    LAS unsigned char* ket = wl; LAS unsigned char* vt = wl + IMG_BYTES;
    const float* lp = la + t0 * 256 + h * 64 + lane;
    float bl = 0.f;
#pragma unroll 16
    for (int t = 0; t < 64; ++t) bl += lp[(size_t)t * 256];
    decay[(size_t)task * 64 + lane] = __expf(bl);
    { const bf16* kp = z + t0 * NZ + ZK + h * 64 + lane; float s = 0.f;
#pragma unroll 2
      for (int t8 = 0; t8 < 8; ++t8) { float e[8];
#pragma unroll
          for (int j = 0; j < 8; ++j) { s += lp[(size_t)(t8 * 8 + j) * 256]; e[j] = bf2f(kp[(size_t)(t8 * 8 + j) * NZ]) * __expf(bl - s); }
          v4u w; w.x = pk2(e[0], e[1]); w.y = pk2(e[2], e[3]); w.z = pk2(e[4], e[5]); w.w = pk2(e[6], e[7]);
          *(LAS v4u*)(ket + lane * IMG_STRIDE + t8 * 16) = w; } }
#pragma unroll 4
    for (int hv = 0; hv < 2; ++hv) {
        load_vt_half(vt, z + t0 * NZ + ZV + h * 128 + hv * 64 + lane, lane);
        LDS_FENCE();
        f32x16 acc[2][2];
#pragma unroll
        for (int tv = 0; tv < 2; ++tv)
#pragma unroll
            for (int td = 0; td < 2; ++td) acc[tv][td] = zero16();
#pragma unroll
        for (int s = 0; s < 4; ++s) { bf16x8 af[2], bfr[2];
#pragma unroll
            for (int q = 0; q < 2; ++q) { af[q] = img_frag(vt, 32 * q + l31, s, hh); bfr[q] = img_frag(ket, 32 * q + l31, s, hh); }
#pragma unroll
            for (int tv = 0; tv < 2; ++tv)
#pragma unroll
                for (int td = 0; td < 2; ++td) acc[tv][td] = MFMA32(af[tv], bfr[td], acc[tv][td]); }
        float* up = U + (size_t)task * 8192 + (size_t)hv * 64 * 64;
#pragma unroll
        for (int tv = 0; tv < 2; ++tv)
#pragma unroll
            for (int td = 0; td < 2; ++td)
#pragma unroll
                for (int r = 0; r < 16; ++r) up[(32 * tv + crow(r, hh)) * 64 + 32 * td + l31] = acc[tv][td][r];
        LDS_FENCE();
    }
}
__device__ __forceinline__ void gla_scan(const float* __restrict__ U, const float* __restrict__ decay, bf16* __restrict__ Sp, int gtid, int gthreads) {
    for (int item = gtid; item < 16 * 4096; item += gthreads) {
        const int bh = item >> 12, e2 = (item & 4095) * 2, d = e2 & 63;
        const float* up = U + (size_t)bh * 128 * 8192 + e2; const float* dp = decay + (size_t)bh * 128 * 64 + d; bf16* sp = Sp + (size_t)bh * 128 * 8192 + e2;
        float s0 = 0.f, s1 = 0.f;
#pragma unroll 8
        for (int n = 0; n < 128; ++n) { const f32x2 u = *(const f32x2*)(up + (size_t)n * 8192); const f32x2 dc = *(const f32x2*)(dp + n * 64);
            *(unsigned*)(sp + (size_t)n * 8192) = pk2(s0, s1); s0 = dc[0] * s0 + u[0]; s1 = dc[1] * s1 + u[1]; }
    }
}
__device__ __forceinline__ void conv_mix(const bf16* __restrict__ z, const float* __restrict__ cw, bf16* __restrict__ mix, int gw, int NGW, int lane) {
    const int c0 = lane * 8;
    float w0[8], w1[8], w2[8];
#pragma unroll
    for (int j = 0; j < 8; ++j) { w0[j] = cw[c0 + j]; w1[j] = cw[512 + c0 + j]; w2[j] = cw[1024 + c0 + j]; }
    for (int run = gw; run < T / 16; run += NGW) {
        const size_t tf = (size_t)run * 16; const bool has_prev = (tf % SEQ) != 0;
        float um2[8], um1[8];
#pragma unroll
        for (int j = 0; j < 8; ++j) { um2[j] = 0.f; um1[j] = 0.f; }
        if (has_prev) {
            const v4u c2 = *(const v4u*)(z + (tf - 2) * NZ + ZCC + c0), x2 = *(const v4u*)(z + (tf - 2) * NZ + ZCX + c0), c1 = *(const v4u*)(z + (tf - 1) * NZ + ZCC + c0), x1 = *(const v4u*)(z + (tf - 1) * NZ + ZCX + c0);
#pragma unroll
            for (int q = 0; q < 4; ++q) { um2[2 * q] = bflo(c2[q]) * bflo(x2[q]); um2[2 * q + 1] = bfhi(c2[q]) * bfhi(x2[q]); um1[2 * q] = bflo(c1[q]) * bflo(x1[q]); um1[2 * q + 1] = bfhi(c1[q]) * bfhi(x1[q]); }
        }
#pragma unroll 4
        for (int t = 0; t < 16; ++t) { const size_t row = tf + t;
            const v4u cb = *(const v4u*)(z + row * NZ + ZCB + c0), cc = *(const v4u*)(z + row * NZ + ZCC + c0), cx = *(const v4u*)(z + row * NZ + ZCX + c0);
            float u[8], o[8];
#pragma unroll
            for (int q = 0; q < 4; ++q) { u[2 * q] = bflo(cc[q]) * bflo(cx[q]); u[2 * q + 1] = bfhi(cc[q]) * bfhi(cx[q]); }
#pragma unroll
            for (int q = 0; q < 4; ++q) { o[2 * q] = bflo(cb[q]) * (w0[2 * q] * um2[2 * q] + w1[2 * q] * um1[2 * q] + w2[2 * q] * u[2 * q]);
                o[2 * q + 1] = bfhi(cb[q]) * (w0[2 * q + 1] * um2[2 * q + 1] + w1[2 * q + 1] * um1[2 * q + 1] + w2[2 * q + 1] * u[2 * q + 1]); }
            v4u w; w.x = pk2(o[0], o[1]); w.y = pk2(o[2], o[3]); w.z = pk2(o[4], o[5]); w.w = pk2(o[6], o[7]);
            *(v4u*)(mix + row * DM + 512 + c0) = w;
#pragma unroll
            for (int j = 0; j < 8; ++j) { um2[j] = um1[j]; um1[j] = u[j]; } }
    }
}
__device__ __forceinline__ bf16x8 pack_step(const f32x16& x, int s) { v4u p; p.x = pk2(x[8 * s], x[8 * s + 1]); p.y = pk2(x[8 * s + 2], x[8 * s + 3]); p.z = pk2(x[8 * s + 4], x[8 * s + 5]); p.w = pk2(x[8 * s + 6], x[8 * s + 7]); return __builtin_bit_cast(bf16x8, p); }
__device__ __forceinline__ bf16x8 img_frag_perm(const LAS unsigned char* img, int row, int s, int hh) {
    const v2u lo = *(const LAS v2u*)(img + row * IMG_STRIDE + (16 * s + 4 * hh) * 2), hi = *(const LAS v2u*)(img + row * IMG_STRIDE + (16 * s + 8 + 4 * hh) * 2);
    v4u w; w.x = lo.x; w.y = lo.y; w.z = hi.x; w.w = hi.y; return __builtin_bit_cast(bf16x8, w); }
__device__ __forceinline__ void gla_a3(LAS unsigned char* wl, int task, const bf16* __restrict__ z, const float* __restrict__ la, const bf16* __restrict__ Sp, const float* __restrict__ hn, bf16* __restrict__ mix, int lane) {
    const int bh = task >> 7, n = task & 127, b = bh >> 2, h = bh & 3, hh = lane >> 5, l31 = lane & 31;
    const size_t t0 = (size_t)b * SEQ + (size_t)n * 64;
    LAS unsigned char* r0 = wl;
    LAS unsigned char* r1 = wl + IMG_BYTES;
    { float s = 0.f; const float* lp = la + t0 * 256 + h * 64 + lane; const bf16* qp = z + t0 * NZ + ZQ + h * 64 + lane; const bf16* kp = z + t0 * NZ + ZK + h * 64 + lane;
#pragma unroll 8
      for (int t = 0; t < 64; ++t) { s += lp[(size_t)t * 256];
          const float qd = bf2f(qp[(size_t)t * NZ]) * 0.125f * __expf(s), kd = bf2f(kp[(size_t)t * NZ]) * __expf(-s);
          *(LAS unsigned short*)(r1 + t * IMG_STRIDE + lane * 2) = (unsigned short)f2bf(qd); *(LAS unsigned short*)(r0 + t * IMG_STRIDE + lane * 2) = (unsigned short)f2bf(kd); } }
    LDS_FENCE();
    bf16x8 qf[2][4], pf0[2], pf1[4];
    {
        f32x16 x00 = zero16(), x01 = zero16(), x11 = zero16();
#pragma unroll
        for (int ti = 0; ti < 2; ++ti)
#pragma unroll
            for (int s = 0; s < 4; ++s) qf[ti][s] = img_frag(r1, 32 * ti + l31, s, hh);
#pragma unroll
        for (int s = 0; s < 4; ++s) { const bf16x8 k0 = img_frag(r0, l31, s, hh), k1 = img_frag(r0, 32 + l31, s, hh);
            x00 = MFMA32(k0, qf[0][s], x00); x01 = MFMA32(k0, qf[1][s], x01); x11 = MFMA32(k1, qf[1][s], x11); }
#pragma unroll
        for (int r = 0; r < 16; ++r) if (crow(r, hh) > l31) { x00[r] = 0.f; x11[r] = 0.f; }
        pf0[0] = pack_step(x00, 0); pf0[1] = pack_step(x00, 1);
        pf1[0] = pack_step(x01, 0); pf1[1] = pack_step(x01, 1); pf1[2] = pack_step(x11, 0); pf1[3] = pack_step(x11, 1);
    }
    LDS_FENCE();
    load_vt_half(r0, z + t0 * NZ + ZV + h * 128 + lane, lane);
    load_vt_half(r1, z + t0 * NZ + ZV + h * 128 + 64 + lane, lane);
    LDS_FENCE();
#pragma unroll
    for (int ti = 0; ti < 2; ++ti) {
        unsigned opq = 0; asm volatile("" : "+v"(opq));
        f32x16 o[2][2];
#pragma unroll
        for (int hv = 0; hv < 2; ++hv)
#pragma unroll
            for (int tv = 0; tv < 2; ++tv) {
                asm volatile("" ::: "memory"); f32x16 acc = zero16(); const LAS unsigned char* img = (hv ? r1 : r0) + opq;
#pragma unroll
                for (int s = 0; s < 4; ++s) { if (ti == 0 && s >= 2) continue;
                    acc = MFMA32(img_frag_perm(img, 32 * tv + l31, s, hh), ti == 0 ? pf0[s & 1] : pf1[s], acc); }
                const bf16* sp = Sp + (size_t)task * 8192 + (size_t)(hv * 64 + 32 * tv + l31) * 64 + 8 * hh + opq;
#pragma unroll
                for (int s = 0; s < 4; ++s) acc = MFMA32(*(const bf16x8*)(sp + 16 * s), qf[ti][s], acc);
                o[hv][tv] = acc; }
        float ss = 0.f;
#pragma unroll
        for (int hv = 0; hv < 2; ++hv)
#pragma unroll
            for (int tv = 0; tv < 2; ++tv)
#pragma unroll
                for (int r = 0; r < 16; ++r) ss += o[hv][tv][r] * o[hv][tv][r];
        ss += __shfl_xor(ss, 32);
        const float rs = rsqrtf(ss * (1.0f / 128.0f) + EPS);
        const size_t row = t0 + 32 * ti + l31;
#pragma unroll
        for (int hv = 0; hv < 2; ++hv)
#pragma unroll
            for (int tv = 0; tv < 2; ++tv)
#pragma unroll
                for (int g = 0; g < 4; ++g) { const int v0 = hv * 64 + 32 * tv + 8 * g + 4 * hh;
                    v2u gw = *(const v2u*)(z + row * NZ + ZG + h * 128 + v0); const f32x4 gn = *(const f32x4*)(hn + h * 128 + v0);
                    asm volatile("" : "+v"(gw.x), "+v"(gw.y) : "v"(rs));
                    const float g0 = bflo(gw.x), g1 = bfhi(gw.x), g2 = bflo(gw.y), g3 = bfhi(gw.y);
                    v2u w; w.x = pk2(o[hv][tv][4 * g] * rs * gn[0] * siluf_(g0), o[hv][tv][4 * g + 1] * rs * gn[1] * siluf_(g1));
                    w.y = pk2(o[hv][tv][4 * g + 2] * rs * gn[2] * siluf_(g2), o[hv][tv][4 * g + 3] * rs * gn[3] * siluf_(g3));
                    *(v2u*)(mix + row * DM + h * 128 + v0) = w;
                    if (g & 1) asm volatile("" ::: "memory"); }
        __builtin_amdgcn_sched_barrier(0);
    }
}
__device__ __forceinline__ void fixup_phase(const float* __restrict__ ghead, const float* __restrict__ uhead, const float* __restrict__ gtail, const float* __restrict__ cw, bf16* __restrict__ act, int gtid, int gthreads) {
    for (int idx = gtid; idx < 128 * 2 * DFF; idx += gthreads) {
        const int pm = idx / (2 * DFF), j = (idx / DFF) & 1, c = idx % DFF;
        if ((pm & 31) == 0) continue;
        const float g0 = ghead[(size_t)(pm * 2 + j) * DFF + c];
        const float t1 = gtail[(size_t)((pm - 1) * 2 + 1) * DFF + c], t0 = gtail[(size_t)((pm - 1) * 2) * DFF + c];
        const float gm1 = j ? ghead[(size_t)(pm * 2) * DFF + c] : t1, gm2 = j ? t1 : t0;
        const float cv = cw[2 * DFF + c] * g0 + cw[DFF + c] * gm1 + cw[c] * gm2;
        act[(size_t)(pm * 256 + j) * DFF + c] = (bf16)f2bf(siluf_(cv) * uhead[(size_t)(pm * 2 + j) * DFF + c]);
    }
}
__device__ __forceinline__ void final_phase(float* __restrict__ hio, const float* __restrict__ ssq3p, const float* __restrict__ fn, int gw, int NGW, int lane) {
    f32x4 g[4];
#pragma unroll
    for (int j = 0; j < 4; ++j) g[j] = ((const f32x4*)fn)[lane + 64 * j];
    for (int m = gw; m < T; m += NGW) { const f32x4 sq = *(const f32x4*)(ssq3p + (size_t)m * 4); const float rs = rsqrtf(((sq[0] + sq[1]) + (sq[2] + sq[3])) * (1.0f / DM) + EPS);
        f32x4* hr = (f32x4*)(hio + (size_t)m * DM) + lane;
#pragma unroll
        for (int j = 0; j < 4; ++j) hr[64 * j] = hr[64 * j] * rs * g[j]; }
}
#define XB_TMO      128
#define XB_XCNT(j)  (256  + 64 * (j))
#define XB_XSUB(j)  (1280 + 64 * (j))
#define XB_XGEN(j)  (2304 + 64 * (j))
#define XB_TOP      3328
#define XB_TOPGEN   3392
#define XCD_BAR_WORDS 3456
#define XB_SPIN_CAP (1u << 18)

__device__ __forceinline__ unsigned xb_ld(unsigned* p)              { return __hip_atomic_load(p, __ATOMIC_RELAXED, __HIP_MEMORY_SCOPE_AGENT); }
__device__ __forceinline__ unsigned xb_add(unsigned* p, unsigned v) { return __hip_atomic_fetch_add(p, v, __ATOMIC_RELAXED, __HIP_MEMORY_SCOPE_AGENT); }
__device__ __forceinline__ unsigned xb_xcc_id() { return (unsigned)__builtin_amdgcn_s_getreg((3 << 11) | 20) & 0xFu; }
#define XB_SPIN(cond, bar) do { unsigned _sp = 0; while (cond) { __builtin_amdgcn_s_sleep(1); \
    if ((++_sp & 255u) == 0u) { if (xb_ld(&(bar)[XB_TMO])) break; if (_sp > XB_SPIN_CAP) { atomicAdd(&(bar)[XB_TMO], 1u); break; } } } } while (0)

struct XcdBarrier {
    unsigned* bar; unsigned x;
    volatile LAS unsigned* st;
};

__device__ __forceinline__ XcdBarrier xcd_barrier_post(unsigned* bar, volatile LAS unsigned* st) {
    XcdBarrier b; b.bar = bar; b.x = xb_xcc_id(); b.st = st;
    if (threadIdx.x == 0) (void)xb_add(&bar[XB_XCNT(b.x)], 1u);
    return b;
}
__device__ __forceinline__ void xcd_barrier_complete(unsigned* bar, unsigned x, unsigned& nloc, unsigned& nx) {
    const unsigned G = gridDim.x * gridDim.y * gridDim.z;
    unsigned sum, cnt, mine, sp = 0u;
    for (;;) {
        sum = 0u; cnt = 0u; mine = 0u;
#pragma unroll
        for (unsigned j = 0; j < 16; ++j) { const unsigned c = xb_ld(&bar[XB_XCNT(j)]); sum += c; cnt += (c > 0u) ? 1u : 0u; mine = (j == x) ? c : mine; }
        if (sum == G) break;
        __builtin_amdgcn_s_sleep(1);
        if ((++sp & 255u) == 0u) { if (xb_ld(&bar[XB_TMO])) break; if (sp > XB_SPIN_CAP) { atomicAdd(&bar[XB_TMO], 1u); break; } }
    }
    nloc = mine > 0u ? mine : 1u; nx = cnt > 0u ? cnt : 1u;
}

__device__ __forceinline__ void xcd_barrier(const XcdBarrier& b) {
    asm volatile("s_waitcnt vmcnt(0)" ::: "memory");
    __syncthreads();
    if (threadIdx.x == 0) {
        unsigned* bar = b.bar;
        __builtin_amdgcn_s_waitcnt(0);
        unsigned nloc = b.st[0], nx = b.st[1];
        if (nloc == 0u) { xcd_barrier_complete(bar, b.x, nloc, nx); b.st[0] = nloc; b.st[1] = nx; }
        const unsigned old = xb_add(&bar[XB_XSUB(b.x)], 1u);
        const unsigned gen = old / nloc;
        if (old + 1u == (gen + 1u) * nloc) {
            __builtin_amdgcn_fence(__ATOMIC_RELEASE, "agent");
            asm volatile("s_waitcnt vmcnt(0)" ::: "memory");
            const unsigned og = xb_add(&bar[XB_TOP], 1u);
            const unsigned tg = og / nx;
            if (og + 1u == (tg + 1u) * nx) xb_add(&bar[XB_TOPGEN], 1u);
            else XB_SPIN(xb_ld(&bar[XB_TOPGEN]) == tg, bar);
            __builtin_amdgcn_fence(__ATOMIC_ACQUIRE, "agent");
            xb_add(&bar[XB_XGEN(b.x)], 1u);
            asm volatile("s_waitcnt vmcnt(0)" ::: "memory");
        } else {
            XB_SPIN(xb_ld(&bar[XB_XGEN(b.x)]) == gen, bar);
            __builtin_amdgcn_fence(__ATOMIC_ACQUIRE, "agent");
            asm volatile("s_waitcnt vmcnt(0)" ::: "memory");
        }
    }
    __syncthreads();
}

constexpr int NWAVES = 8;
constexpr int SCR_BYTES = 147456;
constexpr int MISC_OFF = SCR_BYTES;
constexpr int LDS_BYTES = SCR_BYTES + 1024;
static_assert(NWAVES * WAVE_LDS <= SCR_BYTES, "GLA images");
constexpr size_t WS_BAR = 4096 * 4;
constexpr size_t CTL_ZERO_BYTES = 65536;
#ifndef MK_PER_PHASE
#define MK_PER_PHASE 0
#endif
constexpr int N_PHASES = 11;
#ifndef PROBE_MASK
#define PROBE_MASK 0
#endif
struct Args { const float* in[17]; float* out; unsigned char* ws; int ph_lo, ph_hi; };

__global__ void __launch_bounds__(NWAVES * 64, 2) mk_fwd(Args a) {
    extern __shared__ __attribute__((aligned(16))) unsigned char lds_raw[];
    LAS unsigned char* lds = (LAS unsigned char*)lds_raw;
    volatile LAS unsigned* MISC = (volatile LAS unsigned*)(lds + MISC_OFF);
    unsigned char* ws = a.ws; const int G = gridDim.x, bx = blockIdx.x;
    const int tid = threadIdx.x, lane = tid & 63, wave = __builtin_amdgcn_readfirstlane(tid >> 6);
    const int gw = bx * NWAVES + wave, NGW = G * NWAVES;
    const int lo = a.ph_lo, hi = a.ph_hi;
    for (int u = tid; u < (LDS_BYTES - MISC_OFF) / 4; u += NWAVES * 64) MISC[u] = 0u;
    __syncthreads();
    XcdBarrier bar; bar.bar = (unsigned*)(ws + WS_BAR); bar.x = 0; bar.st = nullptr;
    if (!MK_PER_PHASE) bar = xcd_barrier_post((unsigned*)(ws + WS_BAR), MISC + 8);
#define IN(k) (lo <= (k) && (k) < hi)
#define SEAM(k) do { if (IN(k) && IN((k) + 1)) xcd_barrier(bar); } while (0)
    bf16* WIN = (bf16*)(ws + WS_WIN); bf16* WOUT = (bf16*)(ws + WS_WOUT); bf16* WUP = (bf16*)(ws + WS_WUP); bf16* WDN = (bf16*)(ws + WS_WDN); bf16* WPG = (bf16*)(ws + WS_WPG); bf16* WPP = (bf16*)(ws + WS_WPP);
    float* ssq0 = (float*)(ws + WS_SSQ0); float* ssq1 = (float*)(ws + WS_SSQ1); float* ssq2 = (float*)(ws + WS_SSQ2); float* ssq3 = (float*)(ws + WS_SSQ3); float* decay = (float*)(ws + WS_DECAY);
    bf16* xb = (bf16*)(ws + WS_XB); bf16* Sp = xb; bf16* h1b = xb; bf16* zb = (bf16*)(ws + WS_Z); bf16* act = zb; float* la = (float*)(ws + WS_LA); float* U = (float*)(ws + WS_U); bf16* pp = (bf16*)(ws + WS_U);
    bf16* mix = (bf16*)(ws + WS_MIX); bf16* h2b = mix; bf16* pb = (bf16*)(ws + WS_PB);
    float* ghead = (float*)(ws + WS_GHEAD); float* uhead = (float*)(ws + WS_UHEAD); float* gtail = (float*)(ws + WS_GTAIL);
    if (IN(0)) {
        const ProArgs P{a.in[0], a.in[1], a.in[2], a.in[3], a.in[4], a.in[8], a.in[9], a.in[10], a.in[12], a.in[13], a.in[14], a.in[15], WIN, WOUT, WUP, WDN, WPG, WPP, xb, pb, ssq0};
        phase_prologue(P, lds, gw, NGW, wave, lane);
    }
    SEAM(0);
    if (IN(1)) {
        pg8::Gemm g{xb, WIN, T, NIN, DM}; pg8::StaticOrder S; S.init(T, NIN, G, bx);
        pg8::EpiIn E{ssq0, a.in[5], zb, la};
        pg8::gemm_phase<pg8::EpiIn, pg8::StaticOrder, true, true>(lds, g, S, E);
    }
    SEAM(1);
    if (IN(2)) { for (int task = gw; task < 2048; task += NGW) gla_a1(lds + wave * WAVE_LDS, task, zb, la, U, decay, lane); }
    SEAM(2);
    if (IN(3)) { gla_scan(U, decay, Sp, bx * (NWAVES * 64) + tid, G * NWAVES * 64); conv_mix(zb, a.in[7], mix, gw, NGW, lane); }
    SEAM(3);
    if (IN(4)) { for (int task = gw; task < 2048; task += NGW) gla_a3(lds + wave * WAVE_LDS, task, zb, la, Sp, a.in[6], mix, lane); }
    SEAM(4);
    if (IN(5)) {
        __syncthreads();
        pg8::Gemm g{mix, WOUT, T, DM, DM}; pg8::StaticOrder S; S.init(T, DM, G, bx);
        pg8::EpiRes<0, false, false> E{a.in[0], nullptr, nullptr, h1b, ssq1, nullptr, nullptr};
        pg8::gemm_phase<pg8::EpiRes<0, false, false>, pg8::StaticOrder, true, true>(lds, g, S, E);
    }
    SEAM(5);
    if (IN(6)) {
        pg8::Gemm g{h1b, WUP, T, NUP, DM}; pg8::StaticOrder S; S.init(T, NUP, G, bx);
        pg8::EpiUp E{ssq1, a.in[11], act, ghead, uhead, gtail};
        pg8::gemm_phase<pg8::EpiUp, pg8::StaticOrder, true, true>(lds, g, S, E);
    }
    SEAM(6);
    if (IN(7)) fixup_phase(ghead, uhead, gtail, a.in[11], act, bx * (NWAVES * 64) + tid, G * NWAVES * 64);
    SEAM(7);
    if (IN(8)) {
        { pg8::Gemm g{act, WDN, T, DM, DFF}; pg8::StaticOrder S; S.init(T, DM, G, bx);
          pg8::EpiRes<0, true, false> E{nullptr, h1b, nullptr, h2b, ssq2, nullptr, nullptr};
          pg8::gemm_phase<pg8::EpiRes<0, true, false>, pg8::StaticOrder, true, true>(lds, g, S, E); }
        { pg8::Gemm g{pb, WPP, T, DM, PLE}; pg8::StaticOrder S; S.init(T, DM, G, bx);
          pg8::EpiBf E{pp, DM};
          pg8::gemm_phase<pg8::EpiBf, pg8::StaticOrder, true, true>(lds, g, S, E); }
    }
    SEAM(8);
    if (IN(9)) {
        pg8::Gemm g{h2b, WPG, T, DM, DM}; pg8::StaticOrder S; S.init(T, DM, G, bx);
        pg8::EpiRes<1, true, true> E{nullptr, h2b, a.out, nullptr, ssq3, ssq2, pp};
        pg8::gemm_phase<pg8::EpiRes<1, true, true>, pg8::StaticOrder, true, true>(lds, g, S, E);
    }
    SEAM(9);
    if (IN(10)) final_phase(a.out, ssq3, a.in[16], gw, NGW, lane);
#undef IN
#undef SEAM
}

extern "C" void kernel_launch(void* const* d_in, const int* in_sizes, int n_in, void* d_out, int out_size, void* d_ws, size_t ws_size, hipStream_t stream) {
    static int grid = 0;
    if (grid == 0) {
        if (n_in != 17 || in_sizes[0] != T * DM || out_size != T * DM || ws_size < WS_END) { fprintf(stderr, "kernel_launch: unexpected shapes (n_in %d in0 %d out %d ws %zu)\n", n_in, n_in > 0 ? in_sizes[0] : -1, out_size, ws_size); grid = -1; return; }
        int dev = 0, cus = 0, per_cu = 0;
        if (hipGetDevice(&dev) != hipSuccess || hipDeviceGetAttribute(&cus, hipDeviceAttributeMultiprocessorCount, dev) != hipSuccess) { grid = -1; return; }
        if (hipFuncSetAttribute((const void*)mk_fwd, hipFuncAttributeMaxDynamicSharedMemorySize, LDS_BYTES) != hipSuccess) { fprintf(stderr, "kernel_launch: hipFuncSetAttribute failed\n"); grid = -1; return; }
        if (hipOccupancyMaxActiveBlocksPerMultiprocessor(&per_cu, (const void*)mk_fwd, NWAVES * 64, LDS_BYTES) != hipSuccess || per_cu < 1) { fprintf(stderr, "kernel_launch: occupancy query says %d blocks per CU\n", per_cu); (void)hipGetLastError(); grid = -1; return; }
        grid = cus;
    }
    if (grid < 0) return;
    Args a{}; for (int i = 0; i < 17; ++i) a.in[i] = (const float*)d_in[i]; a.out = (float*)d_out; a.ws = (unsigned char*)d_ws;
#if MK_PER_PHASE
    for (int ph = 0; ph < N_PHASES; ++ph) for (int rep = 0; rep < 1 + ((PROBE_MASK >> ph) & 1); ++rep) { a.ph_lo = ph; a.ph_hi = ph + 1; hipLaunchKernelGGL(mk_fwd, dim3(grid), dim3(NWAVES * 64), LDS_BYTES, stream, a); }
#else
    if (hipMemsetAsync((char*)d_ws + WS_CTL, 0, CTL_ZERO_BYTES, stream) != hipSuccess) { fprintf(stderr, "kernel_launch: memset failed\n"); return; }
    a.ph_lo = 0; a.ph_hi = N_PHASES;
    void* kargs[] = {&a};
    const hipError_t e = hipLaunchCooperativeKernel((const void*)mk_fwd, dim3(grid), dim3(NWAVES * 64), kargs, LDS_BYTES, stream);
    if (e != hipSuccess) fprintf(stderr, "kernel_launch: cooperative launch failed: %s (grid %d)\n", hipGetErrorString(e), grid);
#endif
}
```
